# Optimizing an MI355X kernel written in HIP

```python
import jax, jax.numpy as jnp
from jax import lax
import numpy as np

D_MODEL = 2048
BATCH = 1
SEQ = 8192
DEPTH = 1

SSD_HEADS = 32
SSD_HEAD_DIM = 64
SSD_WIDTH = SSD_HEADS * SSD_HEAD_DIM
SSD_GROUPS = 4
SSD_STATE = 128
SSD_CONV = 4
SSD_CHUNK = 128
SSD_CONV_WIDTH = SSD_WIDTH + 2 * SSD_GROUPS * SSD_STATE
MLSTM_HEADS = 8
MLSTM_QK_DIM = 128
MLSTM_V_DIM = 256
MLSTM_WIDTH = MLSTM_HEADS * MLSTM_V_DIM
MLSTM_CHUNK = 64
GATE_SOFTCAP = 15.0
MIX_WIDTH = SSD_WIDTH + MLSTM_WIDTH
D_FF = -(-8 * D_MODEL // (3 * 256)) * 256
EPS = 1e-6
IN_SIZES = (SSD_WIDTH, SSD_CONV_WIDTH, SSD_HEADS,
            MLSTM_HEADS * MLSTM_QK_DIM, MLSTM_HEADS * MLSTM_QK_DIM,
            MLSTM_WIDTH, MLSTM_WIDTH, MLSTM_HEADS, MLSTM_HEADS)
IN_WIDTH = sum(IN_SIZES)
SPLIT_POINTS = tuple(int(s) for s in np.cumsum(IN_SIZES)[:-1])

kernel_name = "hymba_ssd_mlstm_swiglu_layer"


def rmsnorm(x, g):
    xf = x.astype(jnp.float32)
    y = xf * lax.rsqrt(jnp.mean(xf * xf, axis=-1, keepdims=True) + EPS)
    return (y * g.astype(jnp.float32)).astype(x.dtype)


def softcap(x, cap):
    return cap * jnp.tanh(x / cap)


def ssd_mixer(z, xbc, dt_raw, conv_w, conv_b, dt_bias, a_log, d_skip, norm_g):
    b, L, _ = xbc.shape
    G, R, P, N, CH = SSD_GROUPS, SSD_HEADS // SSD_GROUPS, SSD_HEAD_DIM, SSD_STATE, SSD_CHUNK
    nc = L // CH
    f32 = jnp.float32
    xbc = xbc.astype(f32)
    pad = jnp.pad(xbc, ((0, 0), (SSD_CONV - 1, 0), (0, 0)))
    conv = conv_b.astype(f32)
    for tap in range(SSD_CONV):
        conv = conv + pad[:, tap:tap + L] * conv_w[tap].astype(f32)
    xbc = jax.nn.silu(conv)
    xs, Bm, Cm = jnp.split(xbc, [SSD_WIDTH, SSD_WIDTH + G * N], axis=-1)
    xs = xs.reshape(b, nc, CH, G, R, P)
    Bm = Bm.reshape(b, nc, CH, G, N)
    Cm = Cm.reshape(b, nc, CH, G, N)
    dt = jax.nn.softplus(dt_raw.astype(f32) + dt_bias.astype(f32))
    A = -jnp.exp(a_log.astype(f32))
    dt_c = dt.reshape(b, nc, CH, G, R)
    a_dt = (dt_c * A.reshape(G, R)).transpose(0, 3, 4, 1, 2)
    a_cum = jnp.cumsum(a_dt, axis=-1)
    X = xs * dt_c[..., None]
    seg = a_cum[..., :, None] - a_cum[..., None, :]
    causal = jnp.tril(jnp.ones((CH, CH), dtype=bool))
    Lmat = jnp.exp(jnp.where(causal, seg, -jnp.inf))
    cb = jnp.einsum("bclgn,bcsgn->bcgls", Cm, Bm)
    y_diag = jnp.einsum("bcgls,bgrcls,bcsgrp->bclgrp", cb, Lmat, X)
    decay_states = jnp.exp(a_cum[..., -1:] - a_cum)
    states = jnp.einsum("bclgn,bgrcl,bclgrp->cbgrpn", Bm, decay_states, X)
    chunk_decay = jnp.exp(a_cum[..., -1]).transpose(3, 0, 1, 2)

    def step(carry, inp):
        st, dec = inp
        return carry * dec[..., None, None] + st, carry

    _, prev_states = lax.scan(step, jnp.zeros((b, G, R, P, N), f32), (states, chunk_decay))
    y_off = jnp.einsum("bclgn,cbgrpn,bgrcl->bclgrp", Cm, prev_states, jnp.exp(a_cum))
    y = y_diag + y_off + d_skip.astype(f32).reshape(G, R)[:, :, None] * xs
    y = y.reshape(b, L, SSD_WIDTH) * jax.nn.silu(z.astype(f32))
    yg = y.reshape(b, L, G, SSD_WIDTH // G)
    yg = yg * lax.rsqrt(jnp.mean(yg * yg, axis=-1, keepdims=True) + EPS)
    y = yg.reshape(b, L, SSD_WIDTH) * norm_g.astype(f32)
    return y.astype(z.dtype)


def mlstm_mixer(q, k, v, o_raw, i_raw, f_raw, i_bias, f_bias, norm_g):
    b, L, _ = q.shape
    H, DK, DV, CH = MLSTM_HEADS, MLSTM_QK_DIM, MLSTM_V_DIM, MLSTM_CHUNK
    nc = L // CH
    f32 = jnp.float32
    q = q.astype(f32).reshape(b, nc, CH, H, DK)
    k = k.astype(f32).reshape(b, nc, CH, H, DK) * (DK ** -0.5)
    v = v.astype(f32).reshape(b, nc, CH, H, DV)
    log_i = softcap(i_raw.astype(f32) + i_bias.astype(f32), GATE_SOFTCAP)
    log_f = jax.nn.log_sigmoid(softcap(f_raw.astype(f32) + f_bias.astype(f32), GATE_SOFTCAP))
    log_i = log_i.reshape(b, nc, CH, H).transpose(0, 3, 1, 2)
    log_f = log_f.reshape(b, nc, CH, H).transpose(0, 3, 1, 2)
    bcum = jnp.cumsum(log_f, axis=-1)
    b_last = bcum[..., -1]
    a = b_last[..., None] - bcum + log_i
    m_loc = jnp.max(a, axis=-1)
    w = jnp.exp(a - m_loc[..., None])
    C_loc = jnp.einsum("bhcs,bcshv,bcshk->cbhvk", w, v, k)
    n_loc = jnp.einsum("bhcs,bcshk->cbhk", w, k)

    def step(carry, inp):
        C, n, m = carry
        Cl, nl, bl, ml = inp
        m_new = jnp.maximum(bl + m, ml)
        s_old = jnp.exp(bl + m - m_new)
        s_new = jnp.exp(ml - m_new)
        C_new = s_old[..., None, None] * C + s_new[..., None, None] * Cl
        n_new = s_old[..., None] * n + s_new[..., None] * nl
        return (C_new, n_new, m_new), (C, n, m)

    init = (jnp.zeros((b, H, DV, DK), f32), jnp.zeros((b, H, DK), f32), jnp.zeros((b, H), f32))
    _, (prev_C, prev_n, prev_m) = lax.scan(
        step, init, (C_loc, n_loc, b_last.transpose(2, 0, 1), m_loc.transpose(2, 0, 1)))
    D = bcum[..., :, None] - bcum[..., None, :] + log_i[..., None, :]
    causal = jnp.tril(jnp.ones((CH, CH), dtype=bool))
    D = jnp.where(causal, D, -jnp.inf)
    m_intra = jnp.max(D, axis=-1)
    inter_log = bcum + prev_m.transpose(1, 2, 0)[..., None]
    m_t = jnp.maximum(inter_log, m_intra)
    S = jnp.einsum("bclhk,bcshk->bhcls", q, k) * jnp.exp(D - m_t[..., None])
    w_inter = jnp.exp(inter_log - m_t)
    w_inter_t = w_inter.transpose(0, 2, 3, 1)[..., None]
    num = (jnp.einsum("bhcls,bcshv->bclhv", S, v)
           + w_inter_t * jnp.einsum("bclhk,cbhvk->bclhv", q, prev_C))
    nq = jnp.sum(S, axis=-1) + w_inter * jnp.einsum("bclhk,cbhk->bhcl", q, prev_n)
    den = jnp.maximum(jnp.abs(nq), jnp.exp(-m_t))
    h = num / den.transpose(0, 2, 3, 1)[..., None]
    h = h * lax.rsqrt(jnp.mean(h * h, axis=-1, keepdims=True) + EPS)
    h = h.reshape(b, L, MLSTM_WIDTH) * norm_g.astype(f32)
    h = h * jax.nn.sigmoid(o_raw.astype(f32))
    return h.astype(o_raw.dtype)


def setup_inputs(seed: int = 0) -> dict:
    key = jax.random.key(seed)
    ks = jax.random.split(key, 20)
    f32 = jnp.float32
    nrm = lambda k, shape, scale: jax.random.normal(k, shape, f32) * scale
    x = jax.random.normal(ks[0], (BATCH, SEQ, D_MODEL), f32)
    norm_mix_g = 1.0 + nrm(ks[1], (DEPTH, D_MODEL), 0.02)
    w_in = nrm(ks[2], (DEPTH, D_MODEL, IN_WIDTH), D_MODEL ** -0.5)
    conv_w = nrm(ks[3], (DEPTH, SSD_CONV, SSD_CONV_WIDTH), SSD_CONV ** -0.5)
    conv_b = nrm(ks[4], (DEPTH, SSD_CONV_WIDTH), 0.02)
    dt0 = jnp.exp(jax.random.uniform(ks[5], (DEPTH, SSD_HEADS), f32,
                                     jnp.log(0.001), jnp.log(0.1)))
    dt_bias = dt0 + jnp.log(-jnp.expm1(-dt0))
    a_log = jnp.log(jax.random.uniform(ks[6], (DEPTH, SSD_HEADS), f32, 1.0, 16.0))
    d_skip = 1.0 + nrm(ks[7], (DEPTH, SSD_HEADS), 0.02)
    ssd_norm_g = 1.0 + nrm(ks[8], (DEPTH, SSD_WIDTH), 0.02)
    i_bias = nrm(ks[9], (DEPTH, MLSTM_HEADS), 0.1)
    f_bias = jnp.linspace(3.0, 6.0, MLSTM_HEADS, dtype=f32)[None] + nrm(ks[10], (DEPTH, MLSTM_HEADS), 0.1)
    mlstm_norm_g = 1.0 + nrm(ks[11], (DEPTH, MLSTM_WIDTH), 0.02)
    w_out = nrm(ks[12], (DEPTH, MIX_WIDTH, D_MODEL), MIX_WIDTH ** -0.5)
    norm_ffn_g = 1.0 + nrm(ks[13], (DEPTH, D_MODEL), 0.02)
    w_gate = nrm(ks[14], (DEPTH, D_MODEL, D_FF), D_MODEL ** -0.5)
    w_up = nrm(ks[15], (DEPTH, D_MODEL, D_FF), D_MODEL ** -0.5)
    w_down = nrm(ks[16], (DEPTH, D_FF, D_MODEL), D_FF ** -0.5)
    final_norm_g = 1.0 + nrm(ks[17], (D_MODEL,), 0.02)
    return {"x": x, "norm_mix_g": norm_mix_g, "w_in": w_in, "conv_w": conv_w,
            "conv_b": conv_b, "dt_bias": dt_bias, "a_log": a_log, "d_skip": d_skip,
            "ssd_norm_g": ssd_norm_g, "i_bias": i_bias, "f_bias": f_bias,
            "mlstm_norm_g": mlstm_norm_g, "w_out": w_out, "norm_ffn_g": norm_ffn_g,
            "w_gate": w_gate, "w_up": w_up, "w_down": w_down, "final_norm_g": final_norm_g}


def reference(x, norm_mix_g, w_in, conv_w, conv_b, dt_bias, a_log, d_skip, ssd_norm_g,
              i_bias, f_bias, mlstm_norm_g, w_out, norm_ffn_g, w_gate, w_up, w_down,
              final_norm_g):
    h = x
    for l in range(DEPTH):
        u = rmsnorm(h, norm_mix_g[l])
        proj = jnp.einsum("bsd,de->bse", u, w_in[l])
        z, xbc, dt_raw, q, k, v, o_raw, i_raw, f_raw = jnp.split(proj, SPLIT_POINTS, axis=-1)
        y_ssd = ssd_mixer(z, xbc, dt_raw, conv_w[l], conv_b[l], dt_bias[l], a_log[l],
                          d_skip[l], ssd_norm_g[l])
        y_ml = mlstm_mixer(q, k, v, o_raw, i_raw, f_raw, i_bias[l], f_bias[l], mlstm_norm_g[l])
        y_mix = jnp.concatenate([y_ssd, y_ml], axis=-1)
        h = h + jnp.einsum("bse,ed->bsd", y_mix, w_out[l])
        u = rmsnorm(h, norm_ffn_g[l])
        gate = jnp.einsum("bsd,df->bsf", u, w_gate[l])
        up = jnp.einsum("bsd,df->bsf", u, w_up[l])
        h = h + jnp.einsum("bsf,fd->bsd", jax.nn.silu(gate) * up, w_down[l])
    return rmsnorm(h, final_norm_g)
```

```cpp
#include <hip/hip_runtime.h>
#include <hip/hip_cooperative_groups.h>
#include <cstdio>
namespace cg = cooperative_groups;

#ifndef MK_MULTI
#define MK_MULTI 0
#endif

#define LAS __attribute__((address_space(3)))
typedef unsigned short bf16_t;
typedef short bf16x8 __attribute__((ext_vector_type(8)));
typedef float f32x4 __attribute__((ext_vector_type(4)));
typedef unsigned u32x4 __attribute__((ext_vector_type(4)));
typedef unsigned u32x2 __attribute__((ext_vector_type(2)));

constexpr int L = 8192, DM = 2048, DFF = 5632;
constexpr int NIN_SRC = 11312;
constexpr int NIN_PAD = 11520;
constexpr int NPROJ = 11264;
constexpr int Z_OFF = 0, O_OFF = 2048, XBC_OFF = 4096, Q_OFF = 7168, K_OFF = 8192, V_OFF = 9216;
constexpr int NSM = 48;
constexpr float EPS = 1e-6f;
constexpr int NPH = 9;
constexpr int WGU_TAIL_ITEMS = 1792;

constexpr size_t MiB = 1u << 20;
constexpr size_t WS_WIN = 0;
constexpr size_t WS_U = 45 * MiB;
constexpr size_t WS_STATES = 0;
constexpr size_t WS_H1G = 0;
constexpr size_t WS_WD = 32 * MiB;
constexpr size_t WS_WOUT = 77 * MiB;
constexpr size_t WS_PROJ = 93 * MiB;
constexpr size_t WS_CLOC = 269 * MiB;
constexpr size_t WS_SM = 333 * MiB;
constexpr size_t WS_MISC = 335 * MiB;
constexpr size_t WS_NLOC = WS_MISC;
constexpr size_t WS_BLAST = WS_MISC + 512 * 1024;
constexpr size_t WS_MLOC = WS_BLAST + 4096;
constexpr size_t WS_PM = WS_MLOC + 4096;
constexpr size_t WS_CDEC = WS_PM + 4096;
constexpr size_t WS_SS1 = WS_CDEC + 8192;
constexpr size_t WS_SS2 = WS_SS1 + 32768;
constexpr size_t WS_CNT = WS_SS2 + 32768;
constexpr size_t WS_PART1 = 336 * MiB;
constexpr size_t WS_PART2 = 337 * MiB;
constexpr size_t WS_BAR = 338 * MiB;
constexpr size_t WS_END = 339 * MiB;

constexpr int LDS_BYTES = 163840;

__device__ __forceinline__ unsigned cvt_pk_bf16(float lo, float hi) { unsigned r; asm volatile("v_cvt_pk_bf16_f32 %0, %1, %2" : "=v"(r) : "v"(lo), "v"(hi)); return r; }
__device__ __forceinline__ float bflo(unsigned u) { return __uint_as_float(u << 16); }
__device__ __forceinline__ float bfhi(unsigned u) { return __uint_as_float(u & 0xffff0000u); }
__device__ __forceinline__ bf16_t f2bf(float f) { return (bf16_t)(cvt_pk_bf16(f, 0.f) & 0xffffu); }
__device__ __forceinline__ float silu_f(float x) { return x * __builtin_amdgcn_rcpf(1.f + __expf(-x)); }
__device__ __forceinline__ float sigmoid_f(float x) { return __builtin_amdgcn_rcpf(1.f + __expf(-x)); }
__device__ __forceinline__ float softplus_f(float x) { return x > 20.f ? x : log1pf(expf(x)); }
__device__ __forceinline__ float logsigmoid_f(float x) { return fminf(x, 0.f) - log1pf(expf(-fabsf(x))); }
__device__ __forceinline__ float softcap_f(float x) { return 15.f * tanhf(x * (1.f / 15.f)); }
__device__ __forceinline__ float wave_scan_add(float v, int lane) {
#pragma unroll
    for (int o = 1; o < 64; o <<= 1) { const float t = __shfl_up(v, o); if (lane >= o) v += t; }
    return v;
}
__device__ __forceinline__ float wave_scan_max(float v, int lane) {
#pragma unroll
    for (int o = 1; o < 64; o <<= 1) { const float t = __shfl_up(v, o); if (lane >= o) v = fmaxf(v, t); }
    return v;
}
__device__ __forceinline__ float wave_max(float v) {
#pragma unroll
    for (int o = 1; o < 64; o <<= 1) v = fmaxf(v, __shfl_xor(v, o));
    return v;
}
__device__ __forceinline__ float wave_sum(float v) {
#pragma unroll
    for (int o = 1; o < 64; o <<= 1) v += __shfl_xor(v, o);
    return v;
}
#define LDS_WAIT() asm volatile("s_waitcnt lgkmcnt(0)" ::: "memory")
__device__ __forceinline__ float sload_f(const float* p, int idx) { float r; asm volatile("s_load_dword %0, %1, %2\n\ts_waitcnt lgkmcnt(0)" : "=s"(r) : "s"(p), "s"(idx * 4) : "memory"); return r; }

namespace pg8 {
#define PG8_LAS __attribute__((address_space(3)))
constexpr int BM = 256, BK = 64, HALF = 128, HTB = HALF * BK * 2, STAGE_BYTES = 8 * HTB, NXCD = 8, WGM = 4;
__host__ __device__ __forceinline__ int lds_byte(int r, int c) { const int st = (r >> 4) * 2 + (c >> 5), rr = r & 15, cc = c & 31, ob = rr * 64 + cc * 2; return st * 1024 + (ob ^ (((ob >> 9) & 1) << 5)); }
__host__ __device__ __forceinline__ void stage_rc(int b, int& R, int& C) { const int st = b / 1024, sb = b % 1024, swz = sb ^ (((sb >> 9) & 1) << 5); R = (st >> 1) * 16 + swz / 64; C = (st & 1) * 32 + (swz % 64) / 2; }
__host__ __device__ __forceinline__ int perm32(int rho) { const int n = rho >> 4, i = rho & 15; return 8 * (i >> 2) + 4 * n + (i & 3); }
struct Unit { int pm, pn; };
struct Gemm { const bf16_t* A; const bf16_t* Bt; int M, N, K, lda; };
struct StaticOrder {
    int nM, nN, nwg, G, c;
    __device__ void init(int M, int N, int G_, int c_) { nM = M / BM; nN = N / BM; nwg = nM * nN; G = G_; c = c_; }
    __device__ bool next(int i, Unit& u) const {
        const long Lx = (long)i * G + c; if (Lx >= nwg) return false;
        int wgid = (int)Lx; { const int q = nwg / NXCD, r = nwg % NXCD, xcd = wgid % NXCD, off = wgid / NXCD; wgid = (xcd < r ? xcd * (q + 1) : r * (q + 1) + (xcd - r) * q) + off; }
        const int nig = WGM * nN, gid = wgid / nig, fm = gid * WGM, gsz = (nM - fm) < WGM ? (nM - fm) : WGM;
        u.pm = fm + ((wgid % nig) % gsz); u.pn = (wgid % nig) / gsz; return true;
    }
};
template <class Epi>
__device__ __forceinline__ void gemm_phase(PG8_LAS unsigned char* lds, const Gemm g, const StaticOrder& S, const Epi& E, const int tid) {
    const int wid = __builtin_amdgcn_readfirstlane(tid >> 6), lane = tid & 63, wr = wid >> 2, wc = wid & 3, fr = lane & 15, fq = lane >> 4;
    const int K = g.K, nt = K / BK, lda = g.lda;
    unsigned voffA[2], voffB[2];
#pragma unroll
    for (int i = 0; i < 2; ++i) { int R, C; stage_rc(tid * 16 + i * 8192, R, C); const int Rb = Epi::PERM ? ((R & ~31) + perm32(R & 31)) : R;
        voffA[i] = (unsigned)(R * lda + C) * 2u; voffB[i] = (unsigned)(Rb * K + C) * 2u; }
    const size_t kstep = (size_t)(BK * 2);
    const size_t hstepA = (size_t)HALF * lda * 2, hstepB = (size_t)HALF * K * 2;
    const size_t tstepA = 2 * hstepA, tstepB = 2 * hstepB;
    const unsigned ldsw = (unsigned)wid * 1024u;
    const int aoff = lds_byte(wr * 64 + fr, fq * 8), boff = lds_byte(wc * 32 + fr, fq * 8);
#define PG8_SA(b, h) (((b) * 2 + (h)) * HTB)
#define PG8_SB(b, h) ((4 + (b) * 2 + (h)) * HTB)
#define PG8_STAGE(bufoff, gbase, voff) do { _Pragma("unroll") for (int _i = 0; _i < 2; ++_i) \
        __builtin_amdgcn_global_load_lds((const unsigned*)((const char*)(gbase) + (voff)[_i]), (PG8_LAS unsigned*)(lds + (bufoff) + ldsw + _i * 8192), 16, 0, 0); } while (0)
#define PG8_LDA(dst, b, h) do { _Pragma("unroll") for (int m = 0; m < 4; ++m) _Pragma("unroll") for (int k = 0; k < 2; ++k) dst[m][k] = *(const PG8_LAS bf16x8*)(lds + PG8_SA(b, h) + aoff + m * 2048 + k * 1024); } while (0)
#define PG8_LDB(dst, b, h) do { _Pragma("unroll") for (int n = 0; n < 2; ++n) _Pragma("unroll") for (int k = 0; k < 2; ++k) dst[n][k] = *(const PG8_LAS bf16x8*)(lds + PG8_SB(b, h) + boff + n * 2048 + k * 1024); } while (0)
#define PG8_MMA(ai, bj, At, Bt) do { __builtin_amdgcn_s_setprio(1); _Pragma("unroll") for (int m = 0; m < 4; ++m) _Pragma("unroll") for (int n = 0; n < 2; ++n) _Pragma("unroll") for (int k = 0; k < 2; ++k) \
        acc[ai][bj][m][n] = __builtin_amdgcn_mfma_f32_16x16x32_bf16(Bt[n][k], At[m][k], acc[ai][bj][m][n], 0, 0, 0); __builtin_amdgcn_s_setprio(0); } while (0)
#define PG8_WAIT_V(n) asm volatile("s_waitcnt vmcnt(" #n ")" ::: "memory")
#define PG8_WAIT_L(n) asm volatile("s_waitcnt lgkmcnt(" #n ")" ::: "memory")
#define PG8_BAR __builtin_amdgcn_s_barrier()
#define PG8_SCHED __builtin_amdgcn_sched_barrier(0)
    Unit cur, nxt; int ui = 0;
    if (!S.next(0, cur)) return;
    f32x4 acc[2][2][4][2];
#pragma unroll
    for (int a = 0; a < 2; ++a)
#pragma unroll
        for (int b = 0; b < 2; ++b)
#pragma unroll
            for (int m = 0; m < 4; ++m)
#pragma unroll
                for (int n = 0; n < 2; ++n) acc[a][b][m][n] = (f32x4){0.f, 0.f, 0.f, 0.f};
    bf16x8 At[4][2], B0[2][2], B1[2][2];
    const char* cA = (const char*)g.A + (size_t)cur.pm * tstepA; const char* cB = (const char*)g.Bt + (size_t)cur.pn * tstepB;
    PG8_STAGE(PG8_SB(0, 0), cB, voffB); PG8_STAGE(PG8_SA(0, 0), cA, voffA); PG8_STAGE(PG8_SB(0, 1), cB + hstepB, voffB); PG8_STAGE(PG8_SA(0, 1), cA + hstepA, voffA);
    if (wr == 1) PG8_BAR;
    PG8_WAIT_V(4); PG8_BAR;
    PG8_STAGE(PG8_SB(1, 0), cB + kstep, voffB); PG8_STAGE(PG8_SA(1, 0), cA + kstep, voffA); PG8_STAGE(PG8_SB(1, 1), cB + hstepB + kstep, voffB);
    PG8_WAIT_V(6); PG8_BAR;
    for (;;) {
        const bool has_next = S.next(ui + 1, nxt);
        const char* nA = has_next ? (const char*)g.A + (size_t)nxt.pm * tstepA : cA; const char* nB = has_next ? (const char*)g.Bt + (size_t)nxt.pn * tstepB : cB;
        for (int t = 0; t < nt; t += 2) {
            const bool last = (t == nt - 2);
            const char* a1 = cA + (size_t)(t + 1) * kstep;
            const char* a2 = last ? nA : cA + (size_t)(t + 2) * kstep; const char* b2 = last ? nB : cB + (size_t)(t + 2) * kstep;
            const char* a3 = a2 + kstep; const char* b3 = b2 + kstep;
            PG8_LDB(B0, 0, 0); PG8_SCHED; PG8_LDA(At, 0, 0); PG8_STAGE(PG8_SA(1, 1), a1 + hstepA, voffA);
            PG8_WAIT_L(8); PG8_BAR; PG8_WAIT_L(0); PG8_MMA(0, 0, At, B0); PG8_BAR; PG8_SCHED;
            PG8_LDB(B1, 0, 1); PG8_STAGE(PG8_SB(0, 0), b2, voffB);
            PG8_BAR; PG8_WAIT_L(0); PG8_MMA(0, 1, At, B1); PG8_BAR;
            PG8_LDA(At, 0, 1); PG8_STAGE(PG8_SA(0, 0), a2, voffA);
            PG8_BAR; PG8_WAIT_L(0); PG8_MMA(1, 0, At, B0); PG8_BAR; PG8_SCHED;
            PG8_STAGE(PG8_SB(0, 1), b2 + hstepB, voffB);
            PG8_WAIT_V(6); PG8_BAR; PG8_MMA(1, 1, At, B1); PG8_BAR;
            PG8_LDB(B0, 1, 0); PG8_SCHED; PG8_LDA(At, 1, 0); PG8_STAGE(PG8_SA(0, 1), a2 + hstepA, voffA);
            PG8_WAIT_L(8); PG8_BAR; PG8_WAIT_L(0); PG8_MMA(0, 0, At, B0); PG8_BAR; PG8_SCHED;
            PG8_LDB(B1, 1, 1); PG8_STAGE(PG8_SB(1, 0), b3, voffB);
            PG8_BAR; PG8_WAIT_L(0); PG8_MMA(0, 1, At, B1); PG8_BAR;
            PG8_LDA(At, 1, 1); PG8_STAGE(PG8_SA(1, 0), a3, voffA);
            PG8_BAR; PG8_WAIT_L(0); PG8_MMA(1, 0, At, B0); PG8_BAR; PG8_SCHED;
            PG8_STAGE(PG8_SB(1, 1), b3 + hstepB, voffB);
            PG8_WAIT_V(6); PG8_BAR; PG8_MMA(1, 1, At, B1); PG8_BAR;
        }
        if constexpr (!Epi::AFTER_DRAIN) E(acc, cur, wr, wc, fr, fq);
        if (!has_next) break;
#pragma unroll
        for (int a = 0; a < 2; ++a)
#pragma unroll
            for (int b = 0; b < 2; ++b)
#pragma unroll
                for (int m = 0; m < 4; ++m)
#pragma unroll
                    for (int n = 0; n < 2; ++n) acc[a][b][m][n] = (f32x4){0.f, 0.f, 0.f, 0.f};
        cur = nxt; cA = nA; cB = nB; ++ui;
    }
    PG8_WAIT_V(0);
    if (wr == 0) PG8_BAR;
    PG8_BAR;
    if constexpr (Epi::AFTER_DRAIN) E(acc, cur, wr, wc, fr, fq);
#undef PG8_SA
#undef PG8_SB
#undef PG8_STAGE
#undef PG8_LDA
#undef PG8_LDB
#undef PG8_MMA
#undef PG8_WAIT_V
#undef PG8_WAIT_L
#undef PG8_BAR
#undef PG8_SCHED
}
}
using pg8::Unit;

struct EpiProj {
    static constexpr bool PERM = true, AFTER_DRAIN = false;
    bf16_t* O; float* SM;
    __device__ __forceinline__ void operator()(const f32x4 (&acc)[2][2][4][2], const Unit& u, int wr, int wc, int fr, int fq) const {
        const int row0 = u.pm * 256 + wr * 64 + fr;
        if (u.pn < 44) {
            const int col0 = u.pn * 256 + wc * 32 + 8 * fq;
#pragma unroll
            for (int ai = 0; ai < 2; ++ai)
#pragma unroll
                for (int m = 0; m < 4; ++m) { bf16_t* rowp = O + (size_t)(row0 + ai * 128 + m * 16) * NPROJ + col0;
#pragma unroll
                    for (int bj = 0; bj < 2; ++bj) { const f32x4 v0 = acc[ai][bj][m][0], v1 = acc[ai][bj][m][1];
                        u32x4 w; w.x = cvt_pk_bf16(v0[0], v0[1]); w.y = cvt_pk_bf16(v0[2], v0[3]); w.z = cvt_pk_bf16(v1[0], v1[1]); w.w = cvt_pk_bf16(v1[2], v1[3]);
                        *(u32x4*)(rowp + bj * 128) = w; } }
        } else {
            if (wc < 2) {
#pragma unroll
                for (int ai = 0; ai < 2; ++ai)
#pragma unroll
                    for (int m = 0; m < 4; ++m) { float* rowp = SM + (size_t)(row0 + ai * 128 + m * 16) * NSM;
#pragma unroll
                        for (int n = 0; n < 2; ++n) { const int c = wc * 32 + 8 * fq + 4 * n; if (c < NSM) *(f32x4*)(rowp + c) = acc[ai][0][m][n]; } }
            }
        }
    }
};
struct EpiOut {
    static constexpr bool PERM = false, AFTER_DRAIN = false;
    const float* x; float* h1; bf16_t* h1g; const float* g; float* ss;
    __device__ __forceinline__ void operator()(const f32x4 (&acc)[2][2][4][2], const Unit& u, int wr, int wc, int fr, int fq) const {
        const int row0 = u.pm * 256 + wr * 64 + fr, col0 = u.pn * 256 + wc * 32 + 4 * fq;
#pragma unroll
        for (int ai = 0; ai < 2; ++ai)
#pragma unroll
            for (int m = 0; m < 4; ++m) { const int row = row0 + ai * 128 + m * 16; const size_t off = (size_t)row * DM + col0; float s = 0.f;
#pragma unroll
                for (int bj = 0; bj < 2; ++bj)
#pragma unroll
                    for (int n = 0; n < 2; ++n) { const int co = bj * 128 + n * 16; const f32x4 xv = *(const f32x4*)(x + off + co); const f32x4 h = xv + acc[ai][bj][m][n];
                        *(f32x4*)(h1 + off + co) = h; s += (h[0] * h[0] + h[1] * h[1]) + (h[2] * h[2] + h[3] * h[3]);
                        const f32x4 gv = *(const f32x4*)(g + col0 + co); u32x2 w; w.x = cvt_pk_bf16(h[0] * gv[0], h[1] * gv[1]); w.y = cvt_pk_bf16(h[2] * gv[2], h[3] * gv[3]);
                        *(u32x2*)(h1g + off + co) = w; }
                s += __shfl_xor(s, 16); s += __shfl_xor(s, 32);
                if (fq == 0) atomicAdd(ss + row, s); }
    }
};
template <bool DET> struct EpiGUT {
    static constexpr bool PERM = true, AFTER_DRAIN = false;
    bf16_t* act; const float* ss;
    __device__ __forceinline__ void operator()(const f32x4 (&acc)[2][2][4][2], const Unit& u, int wr, int wc, int fr, int fq) const {
        const int row0 = u.pm * 256 + wr * 64 + fr, f0 = u.pn * 128 + wc * 32 + 8 * fq;
#pragma unroll
        for (int ai = 0; ai < 2; ++ai)
#pragma unroll
            for (int m = 0; m < 4; ++m) { const int row = row0 + ai * 128 + m * 16; const float r = DET ? ss[row] : __builtin_amdgcn_rsqf(ss[row] * (1.f / DM) + EPS);
                float a[8];
#pragma unroll
                for (int n = 0; n < 2; ++n)
#pragma unroll
                    for (int j = 0; j < 4; ++j) { const float gg = acc[ai][0][m][n][j] * r, uu = acc[ai][1][m][n][j] * r; a[4 * n + j] = silu_f(gg) * uu; }
                u32x4 w; w.x = cvt_pk_bf16(a[0], a[1]); w.y = cvt_pk_bf16(a[2], a[3]); w.z = cvt_pk_bf16(a[4], a[5]); w.w = cvt_pk_bf16(a[6], a[7]);
                *(u32x4*)(act + (size_t)row * DFF + f0) = w; }
    }
};
struct EpiDown {
    static constexpr bool PERM = false, AFTER_DRAIN = false;
    const float* hin; float* h; float* ss;
    __device__ __forceinline__ void operator()(const f32x4 (&acc)[2][2][4][2], const Unit& u, int wr, int wc, int fr, int fq) const {
        const int row0 = u.pm * 256 + wr * 64 + fr, col0 = u.pn * 256 + wc * 32 + 4 * fq;
#pragma unroll
        for (int ai = 0; ai < 2; ++ai)
#pragma unroll
            for (int m = 0; m < 4; ++m) { const int row = row0 + ai * 128 + m * 16; const size_t off = (size_t)row * DM + col0; float s = 0.f;
#pragma unroll
                for (int bj = 0; bj < 2; ++bj)
#pragma unroll
                    for (int n = 0; n < 2; ++n) { const int co = bj * 128 + n * 16; const f32x4 hv = *(const f32x4*)(hin + off + co) + acc[ai][bj][m][n];
                        *(f32x4*)(h + off + co) = hv; s += (hv[0] * hv[0] + hv[1] * hv[1]) + (hv[2] * hv[2] + hv[3] * hv[3]); }
                s += __shfl_xor(s, 16); s += __shfl_xor(s, 32);
                if (fq == 0) atomicAdd(ss + row, s); }
    }
};

struct EpiDownFused {
    static constexpr bool PERM = false, AFTER_DRAIN = true;
    const float* hin; float* h; float* ss; unsigned* cnt; const float* g;
    __device__ __forceinline__ void operator()(f32x4 (&acc)[2][2][4][2], const Unit& u, int wr, int wc, int fr, int fq) const {
        const int row0 = u.pm * 256 + wr * 64 + fr, col0 = u.pn * 256 + wc * 32 + 4 * fq;
        float keep = 0.f;
#pragma unroll
        for (int ai = 0; ai < 2; ++ai)
#pragma unroll
            for (int m = 0; m < 4; ++m) { const int row = row0 + ai * 128 + m * 16; const size_t off = (size_t)row * DM + col0; float sq = 0.f;
#pragma unroll
                for (int bj = 0; bj < 2; ++bj)
#pragma unroll
                    for (int n = 0; n < 2; ++n) { const int co = bj * 128 + n * 16; const f32x4 hv = *(const f32x4*)(hin + off + co) + acc[ai][bj][m][n];
                        acc[ai][bj][m][n] = hv; sq += (hv[0] * hv[0] + hv[1] * hv[1]) + (hv[2] * hv[2] + hv[3] * hv[3]); }
                sq += __shfl_xor(sq, 16); sq += __shfl_xor(sq, 32);
                if (fq == 0) keep += __hip_atomic_fetch_add(ss + row, sq, __ATOMIC_RELAXED, __HIP_MEMORY_SCOPE_AGENT); }
        asm volatile("s_waitcnt vmcnt(0)" :: "v"(keep) : "memory");
        if ((threadIdx.x & 63) == 0) __hip_atomic_fetch_add(cnt + 64 * u.pm, 1u, __ATOMIC_RELAXED, __HIP_MEMORY_SCOPE_AGENT);
        if (threadIdx.x == 0) { unsigned spins = 0;
            while (__hip_atomic_load(cnt + 64 * u.pm, __ATOMIC_RELAXED, __HIP_MEMORY_SCOPE_AGENT) < 64u && ++spins < (1u << 22)) __builtin_amdgcn_s_sleep(2); }
        __syncthreads();
#pragma unroll
        for (int ai = 0; ai < 2; ++ai)
#pragma unroll
            for (int m = 0; m < 4; ++m) { const int row = row0 + ai * 128 + m * 16; const size_t off = (size_t)row * DM + col0;
                const float tot = __hip_atomic_load(ss + row, __ATOMIC_RELAXED, __HIP_MEMORY_SCOPE_AGENT); const float r = __builtin_amdgcn_rsqf(tot * (1.f / DM) + EPS);
#pragma unroll
                for (int bj = 0; bj < 2; ++bj)
#pragma unroll
                    for (int n = 0; n < 2; ++n) { const int co = bj * 128 + n * 16; const f32x4 gv = *(const f32x4*)(g + col0 + co);
                        *(f32x4*)(h + off + co) = acc[ai][bj][m][n] * r * gv; } }
    }
};

__device__ __forceinline__ float row_total(const float* part, int row) {
    float t = 0.f;
#pragma unroll
    for (int k = 0; k < 32; ++k) t += __hip_atomic_load(part + (size_t)row * 32 + k, __ATOMIC_RELAXED, __HIP_MEMORY_SCOPE_AGENT);
    return t;
}
struct EpiOutDet {
    static constexpr bool PERM = false, AFTER_DRAIN = true;
    const float* x; float* h1; bf16_t* h1g; const float* g; float* part; unsigned* cnt; float* rstd;
    __device__ __forceinline__ void operator()(f32x4 (&acc)[2][2][4][2], const Unit& u, int wr, int wc, int fr, int fq) const {
        const int row0 = u.pm * 256 + wr * 64 + fr, col0 = u.pn * 256 + wc * 32 + 4 * fq;
#pragma unroll
        for (int ai = 0; ai < 2; ++ai)
#pragma unroll
            for (int m = 0; m < 4; ++m) { const int row = row0 + ai * 128 + m * 16; const size_t off = (size_t)row * DM + col0; float sq = 0.f;
#pragma unroll
                for (int bj = 0; bj < 2; ++bj)
#pragma unroll
                    for (int n = 0; n < 2; ++n) { const int co = bj * 128 + n * 16; const f32x4 xv = *(const f32x4*)(x + off + co); const f32x4 h = xv + acc[ai][bj][m][n];
                        *(f32x4*)(h1 + off + co) = h; sq += (h[0] * h[0] + h[1] * h[1]) + (h[2] * h[2] + h[3] * h[3]);
                        const f32x4 gv = *(const f32x4*)(g + col0 + co); u32x2 w; w.x = cvt_pk_bf16(h[0] * gv[0], h[1] * gv[1]); w.y = cvt_pk_bf16(h[2] * gv[2], h[3] * gv[3]);
                        *(u32x2*)(h1g + off + co) = w; }
                sq += __shfl_xor(sq, 16); sq += __shfl_xor(sq, 32);
                if (fq == 0) __hip_atomic_store(part + (size_t)row * 32 + u.pn * 4 + wc, sq, __ATOMIC_RELAXED, __HIP_MEMORY_SCOPE_AGENT); }
        asm volatile("s_waitcnt vmcnt(0)" ::: "memory");
        unsigned old = 0u;
        if (fr == 0 && fq == 0) old = __hip_atomic_fetch_add(cnt + 64 * u.pm, 1u, __ATOMIC_RELAXED, __HIP_MEMORY_SCOPE_AGENT);
        old = (unsigned)__builtin_amdgcn_readfirstlane((int)old);
        if (old == 63u) {
            const int lane = fq * 16 + fr;
#pragma unroll
            for (int rr = 0; rr < 4; ++rr) { const int row = u.pm * 256 + lane * 4 + rr; rstd[row] = __builtin_amdgcn_rsqf(row_total(part, row) * (1.f / DM) + EPS); }
        }
    }
};
struct EpiDownDet {
    static constexpr bool PERM = false, AFTER_DRAIN = true;
    const float* hin; float* h; float* part; unsigned* cnt; const float* g; LAS float* sR;
    __device__ __forceinline__ void operator()(f32x4 (&acc)[2][2][4][2], const Unit& u, int wr, int wc, int fr, int fq) const {
        const int row0 = u.pm * 256 + wr * 64 + fr, col0 = u.pn * 256 + wc * 32 + 4 * fq;
#pragma unroll
        for (int ai = 0; ai < 2; ++ai)
#pragma unroll
            for (int m = 0; m < 4; ++m) { const int row = row0 + ai * 128 + m * 16; const size_t off = (size_t)row * DM + col0; float sq = 0.f;
#pragma unroll
                for (int bj = 0; bj < 2; ++bj)
#pragma unroll
                    for (int n = 0; n < 2; ++n) { const int co = bj * 128 + n * 16; const f32x4 hv = *(const f32x4*)(hin + off + co) + acc[ai][bj][m][n];
                        acc[ai][bj][m][n] = hv; sq += (hv[0] * hv[0] + hv[1] * hv[1]) + (hv[2] * hv[2] + hv[3] * hv[3]); }
                sq += __shfl_xor(sq, 16); sq += __shfl_xor(sq, 32);
                if (fq == 0) __hip_atomic_store(part + (size_t)row * 32 + u.pn * 4 + wc, sq, __ATOMIC_RELAXED, __HIP_MEMORY_SCOPE_AGENT); }
        asm volatile("s_waitcnt vmcnt(0)" ::: "memory");
        if (fr == 0 && fq == 0) __hip_atomic_fetch_add(cnt + 64 * u.pm, 1u, __ATOMIC_RELAXED, __HIP_MEMORY_SCOPE_AGENT);
        if (fr == 0 && fq == 0 && wr == 0 && wc == 0) { unsigned spins = 0;
            while (__hip_atomic_load(cnt + 64 * u.pm, __ATOMIC_RELAXED, __HIP_MEMORY_SCOPE_AGENT) < 64u && ++spins < (1u << 22)) __builtin_amdgcn_s_sleep(2); }
        __syncthreads();
        const int tid = (wr * 4 + wc) * 64 + fq * 16 + fr;
        if (tid < 256) sR[tid] = __builtin_amdgcn_rsqf(row_total(part, u.pm * 256 + tid) * (1.f / DM) + EPS);
        __syncthreads();
#pragma unroll
        for (int ai = 0; ai < 2; ++ai)
#pragma unroll
            for (int m = 0; m < 4; ++m) { const int rl = wr * 64 + fr + ai * 128 + m * 16; const size_t off = (size_t)(u.pm * 256 + rl) * DM + col0; const float r = sR[rl];
#pragma unroll
                for (int bj = 0; bj < 2; ++bj)
#pragma unroll
                    for (int n = 0; n < 2; ++n) { const int co = bj * 128 + n * 16; const f32x4 gv = *(const f32x4*)(g + col0 + co);
                        *(f32x4*)(h + off + co) = acc[ai][bj][m][n] * r * gv; } }
    }
};

struct Params {
    const float *x, *norm_mix_g, *w_in, *conv_w, *conv_b, *dt_bias, *a_log, *d_skip, *ssd_norm_g, *i_bias, *f_bias, *mlstm_norm_g, *w_out, *norm_ffn_g, *w_gate, *w_up, *w_down, *final_norm_g;
    float* out; unsigned char* ws; int ph_lo, ph_hi;
};

__device__ __forceinline__ void ti_load(const float* __restrict__ colp, int ldw, int k0, int lane, f32x4 (&v)[16]) {
    const int kq = lane >> 4;
#pragma unroll
    for (int i = 0; i < 16; ++i) v[i] = colp ? __builtin_nontemporal_load((const f32x4*)(colp + (size_t)(k0 + 4 * i + kq) * ldw)) : (f32x4){0.f, 0.f, 0.f, 0.f};
}
__device__ __forceinline__ void ti_to_lds(const f32x4 (&v)[16], LAS float* scr, int lane) {
    const int n4 = (lane & 15) * 4, kq = lane >> 4;
#pragma unroll
    for (int i = 0; i < 16; ++i) { LAS float* d = scr + (4 * i + kq) * 65 + n4; d[0] = v[i][0]; d[1] = v[i][1]; d[2] = v[i][2]; d[3] = v[i][3]; }
}
__device__ __forceinline__ void ti_store(bf16_t* WT, int ldt, int dstrow0, int k0, LAS float* scr, int lane) {
    LDS_WAIT();
    const int c8 = lane & 7;
#pragma unroll
    for (int j = 0; j < 8; ++j) { const int n = (lane >> 3) + 8 * j; const LAS float* sp = scr + (8 * c8) * 65 + n;
        u32x4 o; o.x = cvt_pk_bf16(sp[0 * 65], sp[1 * 65]); o.y = cvt_pk_bf16(sp[2 * 65], sp[3 * 65]); o.z = cvt_pk_bf16(sp[4 * 65], sp[5 * 65]); o.w = cvt_pk_bf16(sp[6 * 65], sp[7 * 65]);
        *(u32x4*)(WT + (size_t)(dstrow0 + n) * ldt + k0 + 8 * c8) = o; }
    LDS_WAIT();
}
struct TItem { const float* colp; int ldw, k0; bf16_t* WT; int ldt, dstrow0; };
__device__ __forceinline__ int win_src_col(int j) {
    if (j < 2048) return j;
    if (j < 4096) return 9248 + (j - 2048);
    if (j < 7168) return 2048 + (j - 4096);
    if (j < 8192) return 5152 + (j - 7168);
    if (j < 9216) return 6176 + (j - 8192);
    if (j < 11264) return 7200 + (j - 9216);
    if (j < 11296) return 5120 + (j - 11264);
    return j;
}

__device__ __forceinline__ TItem titem(const Params& p, unsigned char* ws, int which, int it, int lane) {
    TItem t; const int n4 = (lane & 15) * 4;
    if (which == 0) { const int kb = it / 180, nb = it % 180, j = 64 * nb + n4; t.colp = j < NIN_SRC ? p.w_in + win_src_col(j & ~31) + (j & 31) : nullptr; t.ldw = NIN_SRC; t.k0 = 64 * kb; t.WT = (bf16_t*)(ws + WS_WIN); t.ldt = DM; t.dstrow0 = 64 * nb; }
    else if (which == 1) { const int kb = it / 32, nb = it % 32; t.colp = p.w_out + 64 * nb + n4; t.ldw = DM; t.k0 = 64 * kb; t.WT = (bf16_t*)(ws + WS_WOUT); t.ldt = 4096; t.dstrow0 = 64 * nb; }
    else if (which == 2) { const int kb = it / 176, nb = it % 176, n0 = 64 * nb, pn = n0 >> 8, bj = (n0 >> 7) & 1, i0 = n0 & 127; t.colp = (bj ? p.w_up : p.w_gate) + pn * 128 + i0 + n4; t.ldw = DFF; t.k0 = 64 * kb; t.WT = (bf16_t*)p.out; t.ldt = DM; t.dstrow0 = n0; }
    else { const int kb = it / 32, nb = it % 32; t.colp = p.w_down + 64 * nb + n4; t.ldw = DM; t.k0 = 64 * kb; t.WT = (bf16_t*)(ws + WS_WD); t.ldt = DFF; t.dstrow0 = 64 * nb; }
    return t;
}
__device__ __forceinline__ void convert_items(const Params& p, unsigned char* ws, int which, int first, int nitems, int step, LAS float* scr, int lane) {
    if (first >= nitems) return;
    f32x4 v[16]; TItem cur = titem(p, ws, which, first, lane); ti_load(cur.colp, cur.ldw, cur.k0, lane, v);
    for (int it = first; it < nitems; it += step) {
        ti_to_lds(v, scr, lane);
        TItem nxt = cur; const bool has = it + step < nitems;
        if (has) { nxt = titem(p, ws, which, it + step, lane); ti_load(nxt.colp, nxt.ldw, nxt.k0, lane, v); }
        ti_store(cur.WT, cur.ldt, cur.dstrow0, cur.k0, scr, lane);
        cur = nxt;
    }
}

__device__ __forceinline__ void conv8(const bf16_t* proj, const float* __restrict__ cw, const float* __restrict__ cb, int t, int ch0, float (&o)[8]) {
    const f32x4 b0 = *(const f32x4*)(cb + ch0), b1 = *(const f32x4*)(cb + ch0 + 4);
    float a[8] = {b0[0], b0[1], b0[2], b0[3], b1[0], b1[1], b1[2], b1[3]};
#pragma unroll
    for (int tap = 0; tap < 4; ++tap) { const int tt = t - 3 + tap;
        if (tt >= 0) { const u32x4 r = *(const u32x4*)(proj + (size_t)tt * NPROJ + XBC_OFF + ch0);
            const f32x4 w0 = *(const f32x4*)(cw + tap * 3072 + ch0), w1 = *(const f32x4*)(cw + tap * 3072 + ch0 + 4);
            a[0] += w0[0] * bflo(r.x); a[1] += w0[1] * bfhi(r.x); a[2] += w0[2] * bflo(r.y); a[3] += w0[3] * bfhi(r.y);
            a[4] += w1[0] * bflo(r.z); a[5] += w1[1] * bfhi(r.z); a[6] += w1[2] * bflo(r.w); a[7] += w1[3] * bfhi(r.w); } }
#pragma unroll
    for (int e = 0; e < 8; ++e) o[e] = silu_f(a[e]);
}
__device__ __forceinline__ u32x4 pack8(const float (&o)[8]) { u32x4 w; w.x = cvt_pk_bf16(o[0], o[1]); w.y = cvt_pk_bf16(o[2], o[3]); w.z = cvt_pk_bf16(o[4], o[5]); w.w = cvt_pk_bf16(o[6], o[7]); return w; }
struct ConvW { f32x4 w[4][2]; f32x4 b[2]; };
__device__ __forceinline__ void convw_load(const float* __restrict__ cw, const float* __restrict__ cb, int ch0, ConvW& W) {
    W.b[0] = *(const f32x4*)(cb + ch0); W.b[1] = *(const f32x4*)(cb + ch0 + 4);
#pragma unroll
    for (int tap = 0; tap < 4; ++tap) { W.w[tap][0] = *(const f32x4*)(cw + tap * 3072 + ch0); W.w[tap][1] = *(const f32x4*)(cw + tap * 3072 + ch0 + 4); }
}
template <int R> __device__ __forceinline__ void conv_load(const bf16_t* proj, int t, int ch0, u32x4 (&raw)[R + 3]) {
#pragma unroll
    for (int j = 0; j < R + 3; ++j) { const int tt = t - 3 + j; raw[j] = tt >= 0 ? *(const u32x4*)(proj + (size_t)tt * NPROJ + XBC_OFF + ch0) : (u32x4){0u, 0u, 0u, 0u}; }
}
template <int R> __device__ __forceinline__ void conv_row(const u32x4 (&raw)[R + 3], const ConvW& W, int r, float (&o)[8]) {
    float a[8] = {W.b[0][0], W.b[0][1], W.b[0][2], W.b[0][3], W.b[1][0], W.b[1][1], W.b[1][2], W.b[1][3]};
#pragma unroll
    for (int tap = 0; tap < 4; ++tap) { const u32x4 x = raw[r + tap];
        a[0] += W.w[tap][0][0] * bflo(x.x); a[1] += W.w[tap][0][1] * bfhi(x.x); a[2] += W.w[tap][0][2] * bflo(x.y); a[3] += W.w[tap][0][3] * bfhi(x.y);
        a[4] += W.w[tap][1][0] * bflo(x.z); a[5] += W.w[tap][1][1] * bfhi(x.z); a[6] += W.w[tap][1][2] * bflo(x.w); a[7] += W.w[tap][1][3] * bfhi(x.w); }
#pragma unroll
    for (int e = 0; e < 8; ++e) o[e] = silu_f(a[e]);
}

__device__ __forceinline__ void ssd_gates(const Params& p, const float* SM, int c, int g, LAS float* sDt, LAS float* sAc, int wid, int lane) {
    const int h = 8 * g + wid; const float A = -expf(sload_f(p.a_log, h)), bias = sload_f(p.dt_bias, h);
    float carry = 0.f;
#pragma unroll
    for (int half = 0; half < 2; ++half) { const int l = half * 64 + lane; const int t = c * 128 + l;
        const float dt = softplus_f(SM[(size_t)t * NSM + h] + bias); const float sc = wave_scan_add(dt * A, lane) + carry;
        sDt[wid * 128 + l] = dt; sAc[wid * 128 + l] = sc; carry = __shfl(sc, 63); }
}
#define MFMA16(a, b, c) __builtin_amdgcn_mfma_f32_16x16x32_bf16((a), (b), (c), 0, 0, 0)
#define LDFRAG(base, row, pitch, kel) (*(const LAS bf16x8*)((base) + (size_t)(row) * (pitch) + (kel)))

#define XB_TMO      128
#define XB_XCNT(j)  (256  + 64 * (j))
#define XB_XSUB(j)  (1280 + 64 * (j))
#define XB_XGEN(j)  (2304 + 64 * (j))
#define XB_TOP      3328
#define XB_TOPGEN   3392
#define XCD_BAR_WORDS 3456
#define XB_SPIN_CAP (1u << 18)
__device__ __forceinline__ unsigned xb_ld(unsigned* p)              { return __hip_atomic_load(p, __ATOMIC_RELAXED, __HIP_MEMORY_SCOPE_AGENT); }
__device__ __forceinline__ unsigned xb_add(unsigned* p, unsigned v) { return __hip_atomic_fetch_add(p, v, __ATOMIC_RELAXED, __HIP_MEMORY_SCOPE_AGENT); }
__device__ __forceinline__ unsigned xb_xcc_id() { return (unsigned)__builtin_amdgcn_s_getreg((3 << 11) | 20) & 0xFu; }
#define XB_SPIN(cond, bar) do { unsigned _sp = 0; while (cond) { __builtin_amdgcn_s_sleep(1); \
    if ((++_sp & 255u) == 0u) { if (xb_ld(&(bar)[XB_TMO])) break; if (_sp > XB_SPIN_CAP) { atomicAdd(&(bar)[XB_TMO], 1u); break; } } } } while (0)
struct XcdBarrier { unsigned* bar; unsigned x; volatile LAS unsigned* st; };
__device__ __forceinline__ void xcd_barrier_complete(unsigned* bar, unsigned x, unsigned& nloc, unsigned& nx) {
    const unsigned G = gridDim.x * gridDim.y * gridDim.z;
    unsigned sum, cnt, mine, sp = 0u;
    for (;;) {
        sum = 0u; cnt = 0u; mine = 0u;
#pragma unroll
        for (unsigned j = 0; j < 16; ++j) { const unsigned c = xb_ld(&bar[XB_XCNT(j)]); sum += c; cnt += (c > 0u) ? 1u : 0u; mine = (j == x) ? c : mine; }
        if (sum == G) break;
        __builtin_amdgcn_s_sleep(1);
        if ((++sp & 255u) == 0u) { if (xb_ld(&bar[XB_TMO])) break; if (sp > XB_SPIN_CAP) { atomicAdd(&bar[XB_TMO], 1u); break; } }
    }
    nloc = mine > 0u ? mine : 1u; nx = cnt > 0u ? cnt : 1u;
}
__device__ __forceinline__ void xcd_barrier(const XcdBarrier& b, const bool lead) {
    asm volatile("s_waitcnt vmcnt(0)" ::: "memory");
    __syncthreads();
    if (lead) {
        unsigned* bar = b.bar;
        __builtin_amdgcn_s_waitcnt(0);
        unsigned nloc = b.st[0], nx = b.st[1];
        if (nloc == 0u) { xcd_barrier_complete(bar, b.x, nloc, nx); b.st[0] = nloc; b.st[1] = nx; }
        const unsigned old = xb_add(&bar[XB_XSUB(b.x)], 1u);
        const unsigned gen = old / nloc;
        if (old + 1u == (gen + 1u) * nloc) {
            __builtin_amdgcn_fence(__ATOMIC_RELEASE, "agent");
            asm volatile("s_waitcnt vmcnt(0)" ::: "memory");
            const unsigned og = xb_add(&bar[XB_TOP], 1u);
            const unsigned tg = og / nx;
            if (og + 1u == (tg + 1u) * nx) xb_add(&bar[XB_TOPGEN], 1u);
            else XB_SPIN(xb_ld(&bar[XB_TOPGEN]) == tg, bar);
            __builtin_amdgcn_fence(__ATOMIC_ACQUIRE, "agent");
            xb_add(&bar[XB_XGEN(b.x)], 1u);
            asm volatile("s_waitcnt vmcnt(0)" ::: "memory");
        } else {
            XB_SPIN(xb_ld(&bar[XB_XGEN(b.x)]) == gen, bar);
            __builtin_amdgcn_fence(__ATOMIC_ACQUIRE, "agent");
            asm volatile("s_waitcnt vmcnt(0)" ::: "memory");
        }
    }
    __syncthreads();
}

__device__ __forceinline__ void p2_ssd(const Params& p, LAS unsigned char* lds, const int bid, const int G, const int tid, const int lane, const int wid) {
    unsigned char* ws = p.ws;
    bf16_t* STATES = (bf16_t*)(ws + WS_STATES); bf16_t* PROJ = (bf16_t*)(ws + WS_PROJ); bf16_t* CLOC = (bf16_t*)(ws + WS_CLOC);
    float* SM = (float*)(ws + WS_SM); float* NLOC = (float*)(ws + WS_NLOC); float* BLAST = (float*)(ws + WS_BLAST); float* MLOC = (float*)(ws + WS_MLOC);
    float* PM = (float*)(ws + WS_PM); float* CDEC = (float*)(ws + WS_CDEC);
    (void)STATES; (void)PROJ; (void)CLOC; (void)SM; (void)NLOC; (void)BLAST; (void)MLOC; (void)PM; (void)CDEC;
        {
            LAS bf16_t* sBT = (LAS bf16_t*)(lds); LAS bf16_t* sXT = (LAS bf16_t*)(lds + 34816);
            LAS float* sDt = (LAS float*)(lds + 69632); LAS float* sAc = (LAS float*)(lds + 73728);
            LAS bf16_t* sOutS = (LAS bf16_t*)(lds + 77824);
            for (int unit = bid; unit < 256; unit += G) { const int c = unit >> 2, g = unit & 3, t0 = c * 128;
                const int rb = tid >> 4, ng = tid & 15;
                u32x4 rawB[7]; conv_load<4>(PROJ, t0 + rb * 4, 2048 + g * 128 + ng * 8, rawB);
                __syncthreads();
                ssd_gates(p, SM, c, g, sDt, sAc, wid, lane);
                { ConvW W; convw_load(p.conv_w, p.conv_b, 2048 + g * 128 + ng * 8, W); float o[4][8];
#pragma unroll
                    for (int r = 0; r < 4; ++r) conv_row<4>(rawB, W, r, o[r]);
#pragma unroll
                    for (int e = 0; e < 8; ++e) { u32x2 w; w.x = cvt_pk_bf16(o[0][e], o[1][e]); w.y = cvt_pk_bf16(o[2][e], o[3][e]); *(LAS u32x2*)(sBT + (ng * 8 + e) * 136 + rb * 4) = w; } }
                const int hsel = ng >> 3, pg = ng & 7;
                u32x4 rawX[7]; ConvW W;
#define P2_SSD_LOADS(HP) do { const int ch_ = (8 * g + 2 * (HP) + hsel) * 64 + pg * 8; conv_load<4>(PROJ, t0 + rb * 4, ch_, rawX); convw_load(p.conv_w, p.conv_b, ch_, W); } while (0)
                P2_SSD_LOADS(0);
#pragma unroll 1
                for (int hp = 0; hp < 4; ++hp) {
                    const int hh = 2 * hp + hsel;
                    __syncthreads();
                    { const float aclast = sAc[hh * 128 + 127]; float o[4][8];
#pragma unroll
                        for (int r = 0; r < 4; ++r) { conv_row<4>(rawX, W, r, o[r]); const int l = rb * 4 + r; const float sc = sDt[hh * 128 + l] * __expf(aclast - sAc[hh * 128 + l]);
#pragma unroll
                            for (int e = 0; e < 8; ++e) o[r][e] *= sc; }
#pragma unroll
                        for (int e = 0; e < 8; ++e) { u32x2 w; w.x = cvt_pk_bf16(o[0][e], o[1][e]); w.y = cvt_pk_bf16(o[2][e], o[3][e]); *(LAS u32x2*)(sXT + hsel * 8704 + (pg * 8 + e) * 136 + rb * 4) = w; } }
                    if (hp < 3) P2_SSD_LOADS(hp + 1);
                    __syncthreads();
#pragma unroll
                    for (int hs = 0; hs < 2; ++hs) { const int h2 = 8 * g + 2 * hp + hs;
                        f32x4 acc[4];
#pragma unroll
                        for (int pt = 0; pt < 4; ++pt) acc[pt] = (f32x4){0.f, 0.f, 0.f, 0.f};
#pragma unroll
                        for (int ks = 0; ks < 4; ++ks) { const bf16x8 bfr = LDFRAG(sBT, 16 * wid + (lane & 15), 136, 32 * ks + 8 * (lane >> 4));
#pragma unroll
                            for (int pt = 0; pt < 4; ++pt) { const bf16x8 afr = LDFRAG(sXT + hs * 8704, 16 * pt + (lane & 15), 136, 32 * ks + 8 * (lane >> 4)); acc[pt] = MFMA16(bfr, afr, acc[pt]); } }
#pragma unroll
                        for (int pt = 0; pt < 4; ++pt) { u32x2 o; o.x = cvt_pk_bf16(acc[pt][0], acc[pt][1]); o.y = cvt_pk_bf16(acc[pt][2], acc[pt][3]);
                            *(LAS u32x2*)(sOutS + hs * 8704 + (16 * pt + (lane & 15)) * 136 + 16 * wid + 4 * (lane >> 4)) = o; }
                        if (tid == 0) CDEC[c * 32 + h2] = __expf(sAc[(2 * hp + hs) * 128 + 127]);
                    }
                    __syncthreads();
#pragma unroll
                    for (int j = 0; j < 4; ++j) { const int i = tid + 512 * j, hs = i >> 10, r = i & 1023;
                        *(u32x4*)(STATES + (size_t)(c * 32 + 8 * g + 2 * hp + hs) * 8192 + (size_t)r * 8) = *(const LAS u32x4*)(sOutS + hs * 8704 + (r >> 4) * 136 + (r & 15) * 8); }
                }
            }
        }
}
__device__ __forceinline__ void p2_mlstm(const Params& p, LAS unsigned char* lds, const int bid, const int G, const int tid, const int lane, const int wid) {
    unsigned char* ws = p.ws;
    bf16_t* STATES = (bf16_t*)(ws + WS_STATES); bf16_t* PROJ = (bf16_t*)(ws + WS_PROJ); bf16_t* CLOC = (bf16_t*)(ws + WS_CLOC);
    float* SM = (float*)(ws + WS_SM); float* NLOC = (float*)(ws + WS_NLOC); float* BLAST = (float*)(ws + WS_BLAST); float* MLOC = (float*)(ws + WS_MLOC);
    float* PM = (float*)(ws + WS_PM); float* CDEC = (float*)(ws + WS_CDEC);
    (void)STATES; (void)PROJ; (void)CLOC; (void)SM; (void)NLOC; (void)BLAST; (void)MLOC; (void)PM; (void)CDEC;
        {
            LAS bf16_t* sVT = (LAS bf16_t*)(lds); LAS bf16_t* sKT = (LAS bf16_t*)(lds + 36864); LAS float* sW = (LAS float*)(lds + 55296);
            LAS bf16_t* sOut = (LAS bf16_t*)(lds + 56320);
            const int ks0 = (tid >> 4) * 2, kg = tid & 15, vs0 = (tid >> 5) * 4, vg = tid & 31;
            u32x4 kr[2], vr[4]; float smi = 0.f, smf = 0.f;
#define P2_ML_LOADS(UNIT) do { const int c_ = (UNIT) >> 3, h_ = (UNIT) & 7, t_ = c_ * 64; \
        _Pragma("unroll") for (int r = 0; r < 2; ++r) kr[r] = *(const u32x4*)(PROJ + (size_t)(t_ + ks0 + r) * NPROJ + K_OFF + h_ * 128 + kg * 8); \
        _Pragma("unroll") for (int r = 0; r < 4; ++r) vr[r] = *(const u32x4*)(PROJ + (size_t)(t_ + vs0 + r) * NPROJ + V_OFF + h_ * 256 + vg * 8); \
        smi = SM[(size_t)(t_ + lane) * NSM + 32 + h_]; smf = SM[(size_t)(t_ + lane) * NSM + 40 + h_]; } while (0)
            if (bid < 1024) P2_ML_LOADS(bid);
            for (int unit = bid; unit < 1024; unit += G) { const int c = unit >> 3, h = unit & 7;
                const float li = softcap_f(smi + sload_f(p.i_bias, h));
                const float lf = logsigmoid_f(softcap_f(smf + sload_f(p.f_bias, h)));
                const float bc = wave_scan_add(lf, lane); const float bl = __shfl(bc, 63);
                const float a = bl - bc + li; const float ml = wave_max(a); const float w = __expf(a - ml);
                __syncthreads();
                if (wid == 0) sW[lane] = w;
                { const float sc = 0.08838834764831845f; const unsigned k0[4] = {kr[0].x, kr[0].y, kr[0].z, kr[0].w}, k1[4] = {kr[1].x, kr[1].y, kr[1].z, kr[1].w};
#pragma unroll
                    for (int q = 0; q < 4; ++q) { *(LAS unsigned*)(sKT + (kg * 8 + 2 * q) * 72 + ks0) = cvt_pk_bf16(bflo(k0[q]) * sc, bflo(k1[q]) * sc);
                        *(LAS unsigned*)(sKT + (kg * 8 + 2 * q + 1) * 72 + ks0) = cvt_pk_bf16(bfhi(k0[q]) * sc, bfhi(k1[q]) * sc); } }
                __syncthreads();
                { const float w0 = sW[vs0], w1 = sW[vs0 + 1], w2 = sW[vs0 + 2], w3 = sW[vs0 + 3];
                    const unsigned v0[4] = {vr[0].x, vr[0].y, vr[0].z, vr[0].w}, v1[4] = {vr[1].x, vr[1].y, vr[1].z, vr[1].w}, v2[4] = {vr[2].x, vr[2].y, vr[2].z, vr[2].w}, v3[4] = {vr[3].x, vr[3].y, vr[3].z, vr[3].w};
#pragma unroll
                    for (int q = 0; q < 4; ++q) { u32x2 lo, hi; lo.x = cvt_pk_bf16(bflo(v0[q]) * w0, bflo(v1[q]) * w1); lo.y = cvt_pk_bf16(bflo(v2[q]) * w2, bflo(v3[q]) * w3);
                        hi.x = cvt_pk_bf16(bfhi(v0[q]) * w0, bfhi(v1[q]) * w1); hi.y = cvt_pk_bf16(bfhi(v2[q]) * w2, bfhi(v3[q]) * w3);
                        *(LAS u32x2*)(sVT + (vg * 8 + 2 * q) * 72 + vs0) = lo; *(LAS u32x2*)(sVT + (vg * 8 + 2 * q + 1) * 72 + vs0) = hi; } }
                if (unit + G < 1024) P2_ML_LOADS(unit + G);
                __syncthreads();
                f32x4 acc[16];
#pragma unroll
                for (int vt = 0; vt < 16; ++vt) acc[vt] = (f32x4){0.f, 0.f, 0.f, 0.f};
#pragma unroll
                for (int ks = 0; ks < 2; ++ks) { const bf16x8 bfr = LDFRAG(sKT, 16 * wid + (lane & 15), 72, 32 * ks + 8 * (lane >> 4));
#pragma unroll
                    for (int vt = 0; vt < 16; ++vt) { const bf16x8 afr = LDFRAG(sVT, 16 * vt + (lane & 15), 72, 32 * ks + 8 * (lane >> 4)); acc[vt] = MFMA16(bfr, afr, acc[vt]); } }
#pragma unroll
                for (int vt = 0; vt < 16; ++vt) { u32x2 o; o.x = cvt_pk_bf16(acc[vt][0], acc[vt][1]); o.y = cvt_pk_bf16(acc[vt][2], acc[vt][3]);
                    *(LAS u32x2*)(sOut + (16 * vt + (lane & 15)) * 136 + 16 * wid + 4 * (lane >> 4)) = o; }
                __syncthreads();
#pragma unroll
                for (int j = 0; j < 8; ++j) { const int i = tid + 512 * j; *(u32x4*)(CLOC + (size_t)(c * 8 + h) * 32768 + (size_t)i * 8) = *(const LAS u32x4*)(sOut + (i >> 4) * 136 + (i & 15) * 8); }
                if (tid < 128) { float sacc = 0.f;
#pragma unroll
                    for (int j = 0; j < 8; ++j) { const u32x4 r = *(const LAS u32x4*)(sKT + tid * 72 + 8 * j); const LAS float* wp = sW + 8 * j;
                        sacc += bflo(r.x) * wp[0] + bfhi(r.x) * wp[1] + bflo(r.y) * wp[2] + bfhi(r.y) * wp[3] + bflo(r.z) * wp[4] + bfhi(r.z) * wp[5] + bflo(r.w) * wp[6] + bfhi(r.w) * wp[7]; }
                    NLOC[(size_t)(c * 8 + h) * 128 + tid] = sacc; }
                if (tid == 0) { BLAST[c * 8 + h] = bl; MLOC[c * 8 + h] = ml; }
            }
        }
}
__device__ __forceinline__ void p4_ssd(const Params& p, LAS unsigned char* lds, const int bid, const int G, const int tid, const int lane, const int wid) {
    unsigned char* ws = p.ws;
    bf16_t* STATES = (bf16_t*)(ws + WS_STATES); bf16_t* PROJ = (bf16_t*)(ws + WS_PROJ); bf16_t* CLOC = (bf16_t*)(ws + WS_CLOC);
    float* SM = (float*)(ws + WS_SM); float* NLOC = (float*)(ws + WS_NLOC); float* BLAST = (float*)(ws + WS_BLAST); float* MLOC = (float*)(ws + WS_MLOC);
    float* PM = (float*)(ws + WS_PM); float* CDEC = (float*)(ws + WS_CDEC);
    (void)STATES; (void)PROJ; (void)CLOC; (void)SM; (void)NLOC; (void)BLAST; (void)MLOC; (void)PM; (void)CDEC;
        {
            LAS bf16_t* sB = (LAS bf16_t*)(lds); LAS bf16_t* sM = (LAS bf16_t*)(lds);
            LAS bf16_t* sC = (LAS bf16_t*)(lds + 34816); LAS bf16_t* sXT = (LAS bf16_t*)(lds + 69632); LAS bf16_t* sXs = (LAS bf16_t*)(lds + 87040);
            LAS bf16_t* sS = (LAS bf16_t*)(lds + 105472); LAS float* sDt = (LAS float*)(lds + 122880); LAS float* sAc = (LAS float*)(lds + 126976);
            LAS float* sCW = (LAS float*)(lds + 131072);
            for (int unit = bid; unit < 256; unit += G) { const int c = unit >> 2, g = unit & 3, t0 = c * 128;
                {
                    const int which = tid >> 8, rb = (tid >> 4) & 15, ng = tid & 15, ch0 = 2048 + which * 512 + g * 128 + ng * 8;
                    u32x4 raw[11]; conv_load<8>(PROJ, t0 + rb * 8, ch0, raw); ConvW W; convw_load(p.conv_w, p.conv_b, ch0, W);
                    float cwv[5];
#pragma unroll
                    for (int q = 0; q < 5; ++q) { const int i = tid + 512 * q, hh2 = i / 320, r2 = i % 320, tap = r2 >> 6, ch = (8 * g + hh2) * 64 + (r2 & 63); cwv[q] = tap < 4 ? p.conv_w[tap * 3072 + ch] : p.conv_b[ch]; }
                    __syncthreads();
#pragma unroll
                    for (int q = 0; q < 5; ++q) sCW[tid + 512 * q] = cwv[q];
                    ssd_gates(p, SM, c, g, sDt, sAc, wid, lane);
                    LAS bf16_t* dst = (which ? sC : sB) + (rb * 8) * 136 + ng * 8;
#pragma unroll
                    for (int r = 0; r < 8; ++r) { float o[8]; conv_row<8>(raw, W, r, o); *(LAS u32x4*)(dst + r * 136) = pack8(o); }
                }
                __syncthreads();
                const int ll = lane & 15, lq = lane >> 4, l = 16 * wid + ll;
                f32x4 cb[8];
#pragma unroll
                for (int st = 0; st < 8; ++st) cb[st] = (f32x4){0.f, 0.f, 0.f, 0.f};
#pragma unroll
                for (int ks = 0; ks < 4; ++ks) { const bf16x8 cfr = LDFRAG(sC, l, 136, 32 * ks + 8 * lq);
#pragma unroll
                    for (int st = 0; st < 8; ++st) { const bf16x8 bfr = LDFRAG(sB, 16 * st + ll, 136, 32 * ks + 8 * lq); cb[st] = MFMA16(bfr, cfr, cb[st]); } }
                __syncthreads();
                float ss = 0.f;
                LAS bf16_t* slab = sM + wid * 16 * 136;
                const int nks = (16 * wid + 15) / 32 + 1;
                const int xrb = tid >> 3, xpg = tid & 7;
                u32x4 rawx[5], sv[2]; u32x2 zr[4];
#define SSD_HEAD_LOADS(HH) do { const int h_ = 8 * g + (HH); conv_load<2>(PROJ, t0 + xrb * 2, h_ * 64 + xpg * 8, rawx); \
        _Pragma("unroll") for (int it = 0; it < 2; ++it) { const int i = tid + 512 * it; sv[it] = *(const u32x4*)(STATES + ((size_t)(c * 32 + h_) * 64 + (i >> 4)) * 128 + (i & 15) * 8); } \
        _Pragma("unroll") for (int pt = 0; pt < 4; ++pt) zr[pt] = *(const u32x2*)(PROJ + (size_t)(t0 + l) * NPROJ + Z_OFF + h_ * 64 + 16 * pt + 4 * lq); } while (0)
                SSD_HEAD_LOADS(0);
#pragma unroll 1
                for (int hh = 0; hh < 8; ++hh) { const int h = 8 * g + hh;
                    if (hh > 0) __syncthreads();
                    { ConvW W; { const LAS float* wp = sCW + hh * 320 + xpg * 8;
#pragma unroll
                            for (int tap = 0; tap < 4; ++tap) { W.w[tap][0] = *(const LAS f32x4*)(wp + tap * 64); W.w[tap][1] = *(const LAS f32x4*)(wp + tap * 64 + 4); }
                            W.b[0] = *(const LAS f32x4*)(wp + 256); W.b[1] = *(const LAS f32x4*)(wp + 260); }
                        float o0[8], o1[8]; conv_row<2>(rawx, W, 0, o0); conv_row<2>(rawx, W, 1, o1);
                        *(LAS u32x4*)(sXs + (xrb * 2) * 72 + xpg * 8) = pack8(o0); *(LAS u32x4*)(sXs + (xrb * 2 + 1) * 72 + xpg * 8) = pack8(o1);
                        const float d0 = sDt[hh * 128 + xrb * 2], d1 = sDt[hh * 128 + xrb * 2 + 1];
#pragma unroll
                        for (int e = 0; e < 8; ++e) *(LAS unsigned*)(sXT + (xpg * 8 + e) * 136 + xrb * 2) = cvt_pk_bf16(o0[e] * d0, o1[e] * d1); }
#pragma unroll
                    for (int it = 0; it < 2; ++it) { const int i = tid + 512 * it; *(LAS u32x4*)(sS + (i >> 4) * 136 + (i & 15) * 8) = sv[it]; }
                    u32x2 zc[4];
#pragma unroll
                    for (int pt = 0; pt < 4; ++pt) zc[pt] = zr[pt];
                    if (hh < 7) SSD_HEAD_LOADS(hh + 1);
                    const float acl = sAc[hh * 128 + l];
#pragma unroll
                    for (int st = 0; st < 8; ++st) { float mv[4]; const f32x4 acs = *(const LAS f32x4*)(sAc + hh * 128 + 16 * st + 4 * lq);
#pragma unroll
                        for (int j = 0; j < 4; ++j) { const int sidx = 16 * st + 4 * lq + j; mv[j] = (sidx <= l) ? cb[st][j] * __expf(acl - acs[j]) : 0.f; }
                        u32x2 w; w.x = cvt_pk_bf16(mv[0], mv[1]); w.y = cvt_pk_bf16(mv[2], mv[3]);
                        *(LAS u32x2*)(slab + ll * 136 + 16 * st + 4 * lq) = w; }
                    __syncthreads();
                    f32x4 ad[4], ao[4];
#pragma unroll
                    for (int pt = 0; pt < 4; ++pt) { ad[pt] = (f32x4){0.f, 0.f, 0.f, 0.f}; ao[pt] = (f32x4){0.f, 0.f, 0.f, 0.f}; }
#pragma unroll
                    for (int ks = 0; ks < 4; ++ks) if (ks < nks) { const bf16x8 mfr = LDFRAG(slab, ll, 136, 32 * ks + 8 * lq);
#pragma unroll
                        for (int pt = 0; pt < 4; ++pt) { const bf16x8 xfr = LDFRAG(sXT, 16 * pt + ll, 136, 32 * ks + 8 * lq); ad[pt] = MFMA16(xfr, mfr, ad[pt]); } }
#pragma unroll
                    for (int ks = 0; ks < 4; ++ks) { const bf16x8 cfr = LDFRAG(sC, l, 136, 32 * ks + 8 * lq);
#pragma unroll
                        for (int pt = 0; pt < 4; ++pt) { const bf16x8 sfr = LDFRAG(sS, 16 * pt + ll, 136, 32 * ks + 8 * lq); ao[pt] = MFMA16(sfr, cfr, ao[pt]); } }
                    const float eal = __expf(acl), dsk = sload_f(p.d_skip, h);
#pragma unroll
                    for (int pt = 0; pt < 4; ++pt) { const int pc = 16 * pt + 4 * lq;
                        const u32x2 xr = *(const LAS u32x2*)(sXs + l * 72 + pc);
                        const f32x4 xs = (f32x4){bflo(xr.x), bfhi(xr.x), bflo(xr.y), bfhi(xr.y)}; const f32x4 zz = (f32x4){bflo(zc[pt].x), bfhi(zc[pt].x), bflo(zc[pt].y), bfhi(zc[pt].y)};
                        f32x4 y = ad[pt] + ao[pt] * eal + xs * dsk;
#pragma unroll
                        for (int j = 0; j < 4; ++j) { y[j] *= silu_f(zz[j]); ss += y[j] * y[j]; }
                        u32x2 w; w.x = cvt_pk_bf16(y[0], y[1]); w.y = cvt_pk_bf16(y[2], y[3]);
                        *(u32x2*)(PROJ + (size_t)(t0 + l) * NPROJ + Z_OFF + h * 64 + pc) = w; }
                }
                ss += __shfl_xor(ss, 16); ss += __shfl_xor(ss, 32);
                const float rstd = __builtin_amdgcn_rsqf(ss * (1.f / 512.f) + EPS);
#pragma unroll
                for (int hh = 0; hh < 8; ++hh)
#pragma unroll
                    for (int pt = 0; pt < 4; ++pt) { const int col = (8 * g + hh) * 64 + 16 * pt + 4 * lq; const f32x4 gv = *(const f32x4*)(p.ssd_norm_g + col);
                        u32x2* yp = (u32x2*)(PROJ + (size_t)(t0 + l) * NPROJ + Z_OFF + col); const u32x2 yr = *yp;
                        const f32x4 y = (f32x4){bflo(yr.x), bfhi(yr.x), bflo(yr.y), bfhi(yr.y)} * rstd * gv;
                        u32x2 w; w.x = cvt_pk_bf16(y[0], y[1]); w.y = cvt_pk_bf16(y[2], y[3]);
                        *yp = w; }
            }
        }
}
__device__ __forceinline__ void p4_mlstm(const Params& p, LAS unsigned char* lds, const int bid, const int G, const int tid, const int lane, const int wid) {
    unsigned char* ws = p.ws;
    bf16_t* STATES = (bf16_t*)(ws + WS_STATES); bf16_t* PROJ = (bf16_t*)(ws + WS_PROJ); bf16_t* CLOC = (bf16_t*)(ws + WS_CLOC);
    float* SM = (float*)(ws + WS_SM); float* NLOC = (float*)(ws + WS_NLOC); float* BLAST = (float*)(ws + WS_BLAST); float* MLOC = (float*)(ws + WS_MLOC);
    float* PM = (float*)(ws + WS_PM); float* CDEC = (float*)(ws + WS_CDEC);
    (void)STATES; (void)PROJ; (void)CLOC; (void)SM; (void)NLOC; (void)BLAST; (void)MLOC; (void)PM; (void)CDEC;
        {
            LAS bf16_t* sQ = (LAS bf16_t*)(lds); LAS bf16_t* sK = (LAS bf16_t*)(lds + 17408); LAS bf16_t* sVT = (LAS bf16_t*)(lds + 34816);
            LAS bf16_t* sSl = (LAS bf16_t*)(lds + 71680); LAS float* sBc = (LAS float*)(lds + 90112); LAS float* sG = sBc + 64; LAS float* sMt = sBc + 128; LAS float* sWi = sBc + 192;
            LAS float* sRow = (LAS float*)(lds + 91136); LAS bf16_t* sPC = (LAS bf16_t*)(lds + 91648);
            const int lt = wid & 3, vh = wid >> 2, ll = lane & 15, lq = lane >> 4, l = 16 * lt + ll;
            const int qs0 = (tid >> 4) * 2, kg = tid & 15, vs0 = (tid >> 5) * 4, vg = tid & 31;
            u32x4 qr[2], kr[2], vr[4], pc[8]; f32x4 pnr = (f32x4){0.f, 0.f, 0.f, 0.f}; float smi = 0.f, smf = 0.f, pmv = 0.f;
            LAS float* sPN = (LAS float*)(lds + 161280);
#define P4_ML_LOADS(UNIT) do { const int c_ = (UNIT) >> 3, h_ = (UNIT) & 7, t_ = c_ * 64; \
        _Pragma("unroll") for (int r = 0; r < 2; ++r) { qr[r] = *(const u32x4*)(PROJ + (size_t)(t_ + qs0 + r) * NPROJ + Q_OFF + h_ * 128 + kg * 8); kr[r] = *(const u32x4*)(PROJ + (size_t)(t_ + qs0 + r) * NPROJ + K_OFF + h_ * 128 + kg * 8); } \
        _Pragma("unroll") for (int j = 0; j < 8; ++j) pc[j] = *(const u32x4*)(CLOC + (size_t)(c_ * 8 + h_) * 32768 + (size_t)(tid + 512 * j) * 8); \
        if (tid < 32) pnr = *(const f32x4*)(NLOC + (size_t)(c_ * 8 + h_) * 128 + tid * 4); \
        smi = SM[(size_t)(t_ + lane) * NSM + 32 + h_]; smf = SM[(size_t)(t_ + lane) * NSM + 40 + h_]; pmv = PM[c_ * 8 + h_]; } while (0)
            if (bid < 1024) P4_ML_LOADS(bid);
            for (int unit = bid; unit < 1024; unit += G) { const int c = unit >> 3, h = unit & 7, t0 = c * 64;
#pragma unroll
                for (int r = 0; r < 4; ++r) vr[r] = *(const u32x4*)(PROJ + (size_t)(t0 + vs0 + r) * NPROJ + V_OFF + h * 256 + vg * 8);
                u32x2 orr[8];
#pragma unroll
                for (int vt = 0; vt < 8; ++vt) orr[vt] = *(const u32x2*)(PROJ + (size_t)(t0 + l) * NPROJ + O_OFF + h * 256 + 128 * vh + 16 * vt + 4 * lq);
                {
                    const float li = softcap_f(smi + sload_f(p.i_bias, h));
                    const float lf = logsigmoid_f(softcap_f(smf + sload_f(p.f_bias, h)));
                    const float bc = wave_scan_add(lf, lane); const float gg = li - bc; const float mp = pmv;
                    const float il = bc + mp; const float mi = bc + wave_scan_max(gg, lane); const float mt = fmaxf(il, mi); const float wi = __expf(il - mt);
                    __syncthreads();
                    if (wid == 0) { sBc[lane] = bc; sG[lane] = gg; sMt[lane] = mt; sWi[lane] = wi; }
                }
                { const float sc = 0.08838834764831845f;
#pragma unroll
                    for (int r = 0; r < 2; ++r) { *(LAS u32x4*)(sQ + (qs0 + r) * 136 + kg * 8) = qr[r];
                        u32x4 w; w.x = cvt_pk_bf16(bflo(kr[r].x) * sc, bfhi(kr[r].x) * sc); w.y = cvt_pk_bf16(bflo(kr[r].y) * sc, bfhi(kr[r].y) * sc); w.z = cvt_pk_bf16(bflo(kr[r].z) * sc, bfhi(kr[r].z) * sc); w.w = cvt_pk_bf16(bflo(kr[r].w) * sc, bfhi(kr[r].w) * sc);
                        *(LAS u32x4*)(sK + (qs0 + r) * 136 + kg * 8) = w; }
                    const unsigned v0[4] = {vr[0].x, vr[0].y, vr[0].z, vr[0].w}, v1[4] = {vr[1].x, vr[1].y, vr[1].z, vr[1].w}, v2[4] = {vr[2].x, vr[2].y, vr[2].z, vr[2].w}, v3[4] = {vr[3].x, vr[3].y, vr[3].z, vr[3].w};
#pragma unroll
                    for (int q = 0; q < 4; ++q) { u32x2 lo, hi; lo.x = (v0[q] & 0xffffu) | (v1[q] << 16); lo.y = (v2[q] & 0xffffu) | (v3[q] << 16);
                        hi.x = (v0[q] >> 16) | (v1[q] & 0xffff0000u); hi.y = (v2[q] >> 16) | (v3[q] & 0xffff0000u);
                        *(LAS u32x2*)(sVT + (vg * 8 + 2 * q) * 72 + vs0) = lo; *(LAS u32x2*)(sVT + (vg * 8 + 2 * q + 1) * 72 + vs0) = hi; } }
#pragma unroll
                for (int j = 0; j < 8; ++j) { const int i = tid + 512 * j; *(LAS u32x4*)(sPC + (i >> 4) * 136 + (i & 15) * 8) = pc[j]; }
                if (tid < 32) *(LAS f32x4*)(sPN + tid * 4) = pnr;
                if (unit + G < 1024) P4_ML_LOADS(unit + G);
                __syncthreads();
                f32x4 sacc[4];
#pragma unroll
                for (int st = 0; st < 4; ++st) sacc[st] = (f32x4){0.f, 0.f, 0.f, 0.f};
#pragma unroll
                for (int ks = 0; ks < 4; ++ks) { const bf16x8 qfr = LDFRAG(sQ, l, 136, 32 * ks + 8 * lq);
#pragma unroll
                    for (int st = 0; st < 4; ++st) if (st <= lt) { const bf16x8 kfr = LDFRAG(sK, 16 * st + ll, 136, 32 * ks + 8 * lq); sacc[st] = MFMA16(kfr, qfr, sacc[st]); } }
                LAS bf16_t* slab = sSl + wid * 16 * 72;
                const float mtl = sMt[l], base = sBc[l] - mtl, wil = sWi[l];
                float nq1 = 0.f;
#pragma unroll
                for (int st = 0; st < 4; ++st) { float sv[4]; const f32x4 gs = *(const LAS f32x4*)(sG + 16 * st + 4 * lq);
#pragma unroll
                    for (int j = 0; j < 4; ++j) { const int sidx = 16 * st + 4 * lq + j; sv[j] = (sidx <= l) ? sacc[st][j] * __expf(base + gs[j]) : 0.f; nq1 += sv[j]; }
                    u32x2 w; w.x = cvt_pk_bf16(sv[0], sv[1]); w.y = cvt_pk_bf16(sv[2], sv[3]);
                    *(LAS u32x2*)(slab + ll * 72 + 16 * st + 4 * lq) = w; }
                nq1 += __shfl_xor(nq1, 16); nq1 += __shfl_xor(nq1, 32);
                float nq2 = 0.f;
#pragma unroll
                for (int kk = 0; kk < 4; ++kk) { const u32x4 qq = *(const LAS u32x4*)(sQ + l * 136 + 32 * lq + 8 * kk); const f32x4 n0 = *(const LAS f32x4*)(sPN + 32 * lq + 8 * kk), n1 = *(const LAS f32x4*)(sPN + 32 * lq + 8 * kk + 4);
                    nq2 += bflo(qq.x) * n0[0] + bfhi(qq.x) * n0[1] + bflo(qq.y) * n0[2] + bfhi(qq.y) * n0[3] + bflo(qq.z) * n1[0] + bfhi(qq.z) * n1[1] + bflo(qq.w) * n1[2] + bfhi(qq.w) * n1[3]; }
                nq2 += __shfl_xor(nq2, 16); nq2 += __shfl_xor(nq2, 32);
                const float nq = nq1 + wil * nq2; const float den = fmaxf(fabsf(nq), __expf(-mtl)); const float inv = 1.0f / den;
                LDS_WAIT();
                f32x4 a1[8], a2[8];
#pragma unroll
                for (int vt = 0; vt < 8; ++vt) { a1[vt] = (f32x4){0.f, 0.f, 0.f, 0.f}; a2[vt] = (f32x4){0.f, 0.f, 0.f, 0.f}; }
#pragma unroll
                for (int ks = 0; ks < 2; ++ks) if (32 * ks <= 16 * lt + 15) { const bf16x8 sfr = LDFRAG(slab, ll, 72, 32 * ks + 8 * lq);
#pragma unroll
                    for (int vt = 0; vt < 8; ++vt) { const bf16x8 vfr = LDFRAG(sVT, 128 * vh + 16 * vt + ll, 72, 32 * ks + 8 * lq); a1[vt] = MFMA16(vfr, sfr, a1[vt]); } }
#pragma unroll 1
                for (int ks = 0; ks < 4; ++ks) { const bf16x8 qfr = LDFRAG(sQ, l, 136, 32 * ks + 8 * lq);
#pragma unroll
                    for (int vt = 0; vt < 8; ++vt) { const bf16x8 cfr = LDFRAG(sPC, 128 * vh + 16 * vt + ll, 136, 32 * ks + 8 * lq); a2[vt] = MFMA16(cfr, qfr, a2[vt]); } }
                float hs = 0.f;
#pragma unroll
                for (int vt = 0; vt < 8; ++vt) { a1[vt] = (a1[vt] + a2[vt] * wil) * inv; hs += (a1[vt][0] * a1[vt][0] + a1[vt][1] * a1[vt][1]) + (a1[vt][2] * a1[vt][2] + a1[vt][3] * a1[vt][3]); }
                hs += __shfl_xor(hs, 16); hs += __shfl_xor(hs, 32);
                if (lq == 0) sRow[vh * 64 + l] = hs;
                f32x4 gvv[8];
#pragma unroll
                for (int vt = 0; vt < 8; ++vt) gvv[vt] = *(const f32x4*)(p.mlstm_norm_g + h * 256 + 128 * vh + 16 * vt + 4 * lq);
                __syncthreads();
                const float rstd = __builtin_amdgcn_rsqf((sRow[l] + sRow[64 + l]) * (1.f / 256.f) + EPS);
#pragma unroll
                for (int vt = 0; vt < 8; ++vt) { const int col = h * 256 + 128 * vh + 16 * vt + 4 * lq; bf16_t* op = PROJ + (size_t)(t0 + l) * NPROJ + O_OFF + col;
                    const f32x4 gv = gvv[vt];
                    const f32x4 ov = (f32x4){bflo(orr[vt].x), bfhi(orr[vt].x), bflo(orr[vt].y), bfhi(orr[vt].y)};
                    f32x4 y;
#pragma unroll
                    for (int j = 0; j < 4; ++j) y[j] = a1[vt][j] * rstd * gv[j] * sigmoid_f(ov[j]);
                    u32x2 w; w.x = cvt_pk_bf16(y[0], y[1]); w.y = cvt_pk_bf16(y[2], y[3]);
                    (void)op; *(LAS u32x2*)(sPC + l * 264 + 128 * vh + 16 * vt + 4 * lq) = w; }
                __syncthreads();
#pragma unroll
                for (int j = 0; j < 4; ++j) { const int i = tid + 512 * j, r = i >> 5, c16 = i & 31;
                    *(u32x4*)(PROJ + (size_t)(t0 + r) * NPROJ + O_OFF + h * 256 + c16 * 8) = *(const LAS u32x4*)(sPC + r * 264 + c16 * 8); }
            }
        }
}

__global__ void __launch_bounds__(512, 2) hymba_fwd(Params p) {
    extern __shared__ __attribute__((aligned(16))) unsigned char lds_raw[];
    LAS unsigned char* lds = (LAS unsigned char*)lds_raw;
    cg::grid_group grid = cg::this_grid();
    const int tid = threadIdx.x, lane = tid & 63, wid = __builtin_amdgcn_readfirstlane(tid >> 6);
    const int G = gridDim.x, bid = blockIdx.x;
    unsigned char* ws = p.ws;
#define WS_PTRS bf16_t* WIN = (bf16_t*)(ws + WS_WIN); bf16_t* U = (bf16_t*)(ws + WS_U); bf16_t* STATES = (bf16_t*)(ws + WS_STATES); bf16_t* H1G = (bf16_t*)(ws + WS_H1G); bf16_t* WD = (bf16_t*)(ws + WS_WD); bf16_t* WOUT = (bf16_t*)(ws + WS_WOUT); bf16_t* PROJ = (bf16_t*)(ws + WS_PROJ); bf16_t* ACT = (bf16_t*)(ws + WS_PROJ); bf16_t* CLOC = (bf16_t*)(ws + WS_CLOC); bf16_t* WGU = (bf16_t*)p.out; float* H1 = (float*)(ws + WS_CLOC); float* SM = (float*)(ws + WS_SM); float* NLOC = (float*)(ws + WS_NLOC); float* BLAST = (float*)(ws + WS_BLAST); float* MLOC = (float*)(ws + WS_MLOC); float* PM = (float*)(ws + WS_PM); float* CDEC = (float*)(ws + WS_CDEC); float* SS1 = (float*)(ws + WS_SS1); float* SS2 = (float*)(ws + WS_SS2);
    const int lo = p.ph_lo, hi = p.ph_hi;
    if (lo == 0 && hi == NPH) { volatile LAS unsigned* xb_st = (volatile LAS unsigned*)(lds + LDS_BYTES - 16); if (tid < 4) xb_st[tid] = 0u; __syncthreads();
        if (tid == 0) (void)xb_add(&((unsigned*)(ws + WS_BAR))[XB_XCNT(xb_xcc_id())], 1u); }
#ifndef PH_MASK
#define PH_MASK 0x1ff
#endif
#define PHASE(k) (((PH_MASK >> (k)) & 1) && lo <= (k) && (k) < hi)
#define SEAM(k) do { if (PHASE(k) && PHASE((k) + 1)) { \
        if (lo == 0 && hi == NPH) { XcdBarrier xb_; xb_.bar = (unsigned*)(p.ws + WS_BAR); xb_.x = xb_xcc_id(); xb_.st = (volatile LAS unsigned*)(lds + LDS_BYTES - 16); xcd_barrier(xb_, wid == 0 && __builtin_amdgcn_mbcnt_hi(~0u, __builtin_amdgcn_mbcnt_lo(~0u, 0u)) == 0u); } \
        else { asm volatile("s_waitcnt vmcnt(0) lgkmcnt(0)" ::: "memory"); grid.sync(); asm volatile("s_waitcnt vmcnt(0)" ::: "memory"); __syncthreads(); } } } while (0)

    if (PHASE(0)) {
        WS_PTRS
        LAS float* scr = (LAS float*)(lds + wid * 16640);
        const int gw = bid * 8 + wid, NGW = G * 8;
        convert_items(p, ws, 0, gw, 32 * 180, NGW, scr, lane);
        for (int m = gw; m < L; m += NGW) {
            const f32x4* xr = (const f32x4*)(p.x + (size_t)m * DM) + lane; const f32x4* gr = (const f32x4*)p.norm_mix_g + lane;
            f32x4 v[8]; float s = 0.f;
#pragma unroll
            for (int j = 0; j < 8; ++j) { v[j] = __builtin_nontemporal_load(xr + 64 * j); s += (v[j][0] * v[j][0] + v[j][1] * v[j][1]) + (v[j][2] * v[j][2] + v[j][3] * v[j][3]); }
            const float rstd = __builtin_amdgcn_rsqf(wave_sum(s) * (1.f / DM) + EPS);
            u32x2* o8 = (u32x2*)(U + (size_t)m * DM) + lane;
#pragma unroll
            for (int j = 0; j < 8; ++j) { const f32x4 gv = gr[64 * j]; u32x2 w; w.x = cvt_pk_bf16(v[j][0] * rstd * gv[0], v[j][1] * rstd * gv[1]); w.y = cvt_pk_bf16(v[j][2] * rstd * gv[2], v[j][3] * rstd * gv[3]); o8[64 * j] = w; }
        }
        for (int i = bid * 512 + tid; i < 2 * L + 32 * 64; i += G * 512) SS1[i] = 0.f;
    }
    SEAM(0);

    if (PHASE(1)) {
        WS_PTRS
        pg8::Gemm g{U, WIN, L, NIN_PAD, DM, DM}; pg8::StaticOrder S; S.init(L, NIN_PAD, G, bid);
        EpiProj E{PROJ, SM};
        pg8::gemm_phase<EpiProj>(lds, g, S, E, tid);
        { const int nfull = (L / 256) * (NIN_PAD / 256) - 5 * G;
            if (G == 256 && bid >= nfull) { convert_items(p, ws, 1, (bid - nfull) * 8 + wid, 64 * 32, (G - nfull) * 8, (LAS float*)(lds + wid * 16640), lane);
                convert_items(p, ws, 2, (bid - nfull) * 8 + wid, WGU_TAIL_ITEMS, (G - nfull) * 8, (LAS float*)(lds + wid * 16640), lane); }
            else if (G != 256) { convert_items(p, ws, 1, bid * 8 + wid, 64 * 32, G * 8, (LAS float*)(lds + wid * 16640), lane);
                convert_items(p, ws, 2, bid * 8 + wid, 32 * 176, G * 8, (LAS float*)(lds + wid * 16640), lane); } }
    }
    SEAM(1);

    if (PHASE(2)) {
        WS_PTRS
        p2_ssd(p, lds, bid, G, tid, lane, wid); p2_mlstm(p, lds, bid, G, tid, lane, wid);
    }
    SEAM(2);

    if (PHASE(3)) {
        WS_PTRS
        const int NT = G * 256;
        for (int it0 = (tid < 256) ? bid * 256 + tid : ((tid == 256) ? 2 * 32768 + bid : 0x7fffffff); it0 < 2 * 32768 + 256; it0 += (tid < 256) ? NT : G) {
            if (tid < 256 && it0 >= 2 * 32768) break;
            int it;
            if (it0 < 2 * 32768) { const int blk = it0 >> 8, r = it0 & 255; it = (r < 128) ? (blk * 128 + r) : (32768 + blk * 128 + (r - 128)); } else it = it0;
            if (it < 32768) { const int h = it >> 10, e = (it & 1023) * 8; f32x4 s0 = (f32x4){0.f, 0.f, 0.f, 0.f}, s1 = s0;
                bf16_t* base = STATES + (size_t)h * 8192 + e;
                u32x4 lA[8], lB[8]; float dA[8], dB[8];
#define SSD_SCAN_LOAD(L_, D_, C0) do { _Pragma("unroll") for (int u = 0; u < 8; ++u) { L_[u] = __builtin_nontemporal_load((const u32x4*)(base + (size_t)((C0) + u) * 262144)); D_[u] = CDEC[((C0) + u) * 32 + h]; } } while (0)
#define SSD_SCAN_PROC(L_, D_, C0) do { _Pragma("unroll") for (int u = 0; u < 8; ++u) { u32x4 o; o.x = cvt_pk_bf16(s0[0], s0[1]); o.y = cvt_pk_bf16(s0[2], s0[3]); o.z = cvt_pk_bf16(s1[0], s1[1]); o.w = cvt_pk_bf16(s1[2], s1[3]); \
        *(u32x4*)(base + (size_t)((C0) + u) * 262144) = o; \
        const f32x4 l0 = (f32x4){bflo(L_[u].x), bfhi(L_[u].x), bflo(L_[u].y), bfhi(L_[u].y)}, l1 = (f32x4){bflo(L_[u].z), bfhi(L_[u].z), bflo(L_[u].w), bfhi(L_[u].w)}; \
        s0 = s0 * D_[u] + l0; s1 = s1 * D_[u] + l1; } } while (0)
                SSD_SCAN_LOAD(lA, dA, 0);
                for (int c0 = 0; c0 < 64; c0 += 16) { SSD_SCAN_LOAD(lB, dB, c0 + 8); SSD_SCAN_PROC(lA, dA, c0); if (c0 + 16 < 64) SSD_SCAN_LOAD(lA, dA, c0 + 16); SSD_SCAN_PROC(lB, dB, c0 + 8); }
            } else if (it < 32768 + 32768) { const int j = it - 32768, h = j >> 12, e = (j & 4095) * 8; f32x4 C0 = (f32x4){0.f, 0.f, 0.f, 0.f}, C1 = C0; float m = 0.f;
                bf16_t* base = CLOC + (size_t)h * 32768 + e;
                u32x4 lA[8], lB[8]; float bA[8], bB[8], mA[8], mB[8];
#define ML_SCAN_LOAD(L_, B_, M_, C0_) do { _Pragma("unroll") for (int u = 0; u < 8; ++u) { L_[u] = __builtin_nontemporal_load((const u32x4*)(base + (size_t)((C0_) + u) * 262144)); B_[u] = BLAST[((C0_) + u) * 8 + h]; M_[u] = MLOC[((C0_) + u) * 8 + h]; } } while (0)
#define ML_SCAN_PROC(L_, B_, M_, C0_) do { _Pragma("unroll") for (int u = 0; u < 8; ++u) { u32x4 o; o.x = cvt_pk_bf16(C0[0], C0[1]); o.y = cvt_pk_bf16(C0[2], C0[3]); o.z = cvt_pk_bf16(C1[0], C1[1]); o.w = cvt_pk_bf16(C1[2], C1[3]); \
        *(u32x4*)(base + (size_t)((C0_) + u) * 262144) = o; if (e == 0) PM[((C0_) + u) * 8 + h] = m; \
        const float mn = fmaxf(B_[u] + m, M_[u]); const float so = __expf(B_[u] + m - mn), sn = __expf(M_[u] - mn); \
        const f32x4 l0 = (f32x4){bflo(L_[u].x), bfhi(L_[u].x), bflo(L_[u].y), bfhi(L_[u].y)}, l1 = (f32x4){bflo(L_[u].z), bfhi(L_[u].z), bflo(L_[u].w), bfhi(L_[u].w)}; \
        C0 = C0 * so + l0 * sn; C1 = C1 * so + l1 * sn; m = mn; } } while (0)
                ML_SCAN_LOAD(lA, bA, mA, 0);
                for (int c0 = 0; c0 < 128; c0 += 16) { ML_SCAN_LOAD(lB, bB, mB, c0 + 8); ML_SCAN_PROC(lA, bA, mA, c0); if (c0 + 16 < 128) ML_SCAN_LOAD(lA, bA, mA, c0 + 16); ML_SCAN_PROC(lB, bB, mB, c0 + 8); }
            } else { const int j = it - 32768 - 32768, h = j >> 5, e = (j & 31) * 4; f32x4 n = (f32x4){0.f, 0.f, 0.f, 0.f}; float m = 0.f;
                for (int c0 = 0; c0 < 128; c0 += 8) { f32x4 loc[8]; float blv[8], mlv[8];
#pragma unroll
                    for (int u = 0; u < 8; ++u) { loc[u] = *(const f32x4*)(NLOC + (size_t)((c0 + u) * 8 + h) * 128 + e); blv[u] = BLAST[(c0 + u) * 8 + h]; mlv[u] = MLOC[(c0 + u) * 8 + h]; }
#pragma unroll
                    for (int u = 0; u < 8; ++u) { *(f32x4*)(NLOC + (size_t)((c0 + u) * 8 + h) * 128 + e) = n;
                        const float mn = fmaxf(blv[u] + m, mlv[u]); const float so = __expf(blv[u] + m - mn), sn = __expf(mlv[u] - mn);
                        n = n * so + loc[u] * sn; m = mn; } }
            }
        }
    }
    SEAM(3);

    if (PHASE(4)) {
        WS_PTRS
        p4_ssd(p, lds, bid, G, tid, lane, wid); p4_mlstm(p, lds, bid, G, tid, lane, wid);
    }
    SEAM(4);

    if (PHASE(5)) {
        const int lane = (int)__builtin_amdgcn_mbcnt_hi(~0u, __builtin_amdgcn_mbcnt_lo(~0u, 0u)), tid = wid * 64 + lane; (void)lane;
        WS_PTRS
        __syncthreads();
        LAS float* scr = (LAS float*)(lds + wid * 16640);
        const int gw = bid * 8 + wid, NGW = G * 8;
        if (G != 256) convert_items(p, ws, 3, gw, 88 * 32, NGW, scr, lane);
        else convert_items(p, ws, 2, WGU_TAIL_ITEMS + gw, 32 * 176, NGW, scr, lane);
        __syncthreads();
        pg8::Gemm g{PROJ, WOUT, L, DM, 4096, NPROJ}; pg8::StaticOrder S; S.init(L, DM, G, bid);
        if (G == 256) { EpiOutDet E{p.x, H1, H1G, p.norm_ffn_g, (float*)(ws + WS_PART1), (unsigned*)SS2, SS1}; pg8::gemm_phase<EpiOutDet>(lds, g, S, E, tid); }
        else { EpiOut E{p.x, H1, H1G, p.norm_ffn_g, SS1}; pg8::gemm_phase<EpiOut>(lds, g, S, E, tid); }
    }
    SEAM(5);

    if (PHASE(6)) {
        const int lane = (int)__builtin_amdgcn_mbcnt_hi(~0u, __builtin_amdgcn_mbcnt_lo(~0u, 0u)), tid = wid * 64 + lane; (void)lane;
        WS_PTRS
        pg8::Gemm g{H1G, WGU, L, 2 * DFF, DM, DM}; pg8::StaticOrder S; S.init(L, 2 * DFF, G, bid);
        if (G == 256) { EpiGUT<true> E{ACT, SS1}; pg8::gemm_phase<EpiGUT<true>>(lds, g, S, E, tid); }
        else { EpiGUT<false> E{ACT, SS1}; pg8::gemm_phase<EpiGUT<false>>(lds, g, S, E, tid); }
        { const int nfull = (L / 256) * (2 * DFF / 256) - 5 * G;
            if (G == 256 && bid >= nfull) convert_items(p, ws, 3, (bid - nfull) * 8 + wid, 88 * 32, (G - nfull) * 8, (LAS float*)(lds + wid * 16640), lane); }
    }
    SEAM(6);

    if (PHASE(7)) {
        const int lane = (int)__builtin_amdgcn_mbcnt_hi(~0u, __builtin_amdgcn_mbcnt_lo(~0u, 0u)), tid = wid * 64 + lane; (void)lane;
        WS_PTRS
        pg8::Gemm g{ACT, WD, L, DM, DFF, DFF}; pg8::StaticOrder S; S.init(L, DM, G, bid);
        if (G == 256) { EpiDownDet E{H1, p.out, (float*)(ws + WS_PART2), (unsigned*)(ws + WS_CNT), p.final_norm_g, (LAS float*)lds}; pg8::gemm_phase<EpiDownDet>(lds, g, S, E, tid); }
        else { EpiDown E{H1, p.out, SS2}; pg8::gemm_phase<EpiDown>(lds, g, S, E, tid); }
    }
    if (G != 256) {
    SEAM(7);

    if (PHASE(8)) {
        const int lane = (int)__builtin_amdgcn_mbcnt_hi(~0u, __builtin_amdgcn_mbcnt_lo(~0u, 0u)), tid = wid * 64 + lane; (void)lane;
        WS_PTRS
        const int gw = bid * 8 + wid, NGW = G * 8;
        for (int m = gw; m < L; m += NGW) {
            const float rstd = __builtin_amdgcn_rsqf(SS2[m] * (1.f / DM) + EPS);
            f32x4* xr = (f32x4*)(p.out + (size_t)m * DM) + lane; const f32x4* gr = (const f32x4*)p.final_norm_g + lane;
#pragma unroll
            for (int j = 0; j < 8; ++j) { const f32x4 v = xr[64 * j]; xr[64 * j] = v * rstd * gr[64 * j]; }
        }
    }
    }
#undef WS_PTRS
#undef PHASE
#undef SEAM
}

extern "C" void kernel_launch(void* const* d_in, const int* in_sizes, int n_in, void* d_out, int out_size, void* d_ws, size_t ws_size, hipStream_t stream) {
    static int grid = 0;
    if (grid == 0) {
        if (n_in != 18 || out_size != L * DM || ws_size < WS_END) { fprintf(stderr, "kernel_launch: unexpected shapes (n_in %d out %d ws %zu, need ws %zu)\n", n_in, out_size, ws_size, (size_t)WS_END); grid = -1; return; }
        int dev = 0, cus = 0, per_cu = 0;
        hipGetDevice(&dev); hipDeviceGetAttribute(&cus, hipDeviceAttributeMultiprocessorCount, dev);
        if (hipFuncSetAttribute((const void*)hymba_fwd, hipFuncAttributeMaxDynamicSharedMemorySize, LDS_BYTES) != hipSuccess) { fprintf(stderr, "kernel_launch: hipFuncSetAttribute failed\n"); grid = -1; return; }
        if (hipOccupancyMaxActiveBlocksPerMultiprocessor(&per_cu, (const void*)hymba_fwd, 512, LDS_BYTES) != hipSuccess || per_cu < 1) { fprintf(stderr, "kernel_launch: occupancy query failed (%d)\n", per_cu); (void)hipGetLastError(); grid = -1; return; }
        grid = cus * 1;
        fprintf(stderr, "kernel_launch: cus %d per_cu %d grid %d ws %zu\n", cus, per_cu, grid, ws_size);
    }
    if (grid < 0) return;
    Params p{};
    const float** pp = (const float**)&p;
    for (int i = 0; i < 18; ++i) pp[i] = (const float*)d_in[i];
    p.out = (float*)d_out; p.ws = (unsigned char*)d_ws;
    (void)hipMemsetAsync((char*)d_ws + WS_BAR, 0, XCD_BAR_WORDS * sizeof(unsigned), stream);
#if MK_MULTI
    for (int ph = 0; ph < NPH; ++ph) { p.ph_lo = ph; p.ph_hi = ph + 1; hipLaunchKernelGGL(hymba_fwd, dim3(grid), dim3(512), LDS_BYTES, stream, p); }
#elif defined(PROBE_REPEAT)
    {
        void* args[] = {&p};
        p.ph_lo = 0; p.ph_hi = PROBE_REPEAT + 1;
        (void)hipLaunchCooperativeKernel((const void*)hymba_fwd, dim3(grid), dim3(512), args, LDS_BYTES, stream);
        p.ph_lo = PROBE_REPEAT; p.ph_hi = NPH;
        (void)hipLaunchCooperativeKernel((const void*)hymba_fwd, dim3(grid), dim3(512), args, LDS_BYTES, stream);
    }
#else
    p.ph_lo = 0; p.ph_hi = NPH;
    void* args[] = {&p};
    hipError_t e = hipLaunchCooperativeKernel((const void*)hymba_fwd, dim3(grid), dim3(512), args, LDS_BYTES, stream);
    if (e != hipSuccess) fprintf(stderr, "kernel_launch: cooperative launch failed: %s (grid %d)\n", hipGetErrorString(e), grid);
#endif
}
```

```cpp
#include <hip/hip_runtime.h>
#include <hip/hip_cooperative_groups.h>
#include <cstdio>
namespace cg = cooperative_groups;

#ifndef MK_MULTI
#define MK_MULTI 0
#endif

#define LAS __attribute__((address_space(3)))
typedef unsigned short bf16_t;
typedef short bf16x8 __attribute__((ext_vector_type(8)));
typedef float f32x4 __attribute__((ext_vector_type(4)));
typedef unsigned u32x4 __attribute__((ext_vector_type(4)));
typedef unsigned u32x2 __attribute__((ext_vector_type(2)));

constexpr int L = 8192, DM = 2048, DFF = 5632;
constexpr int NIN_SRC = 11312;
constexpr int NIN_PAD = 11520;
constexpr int NPROJ = 11264;
constexpr int Z_OFF = 0, O_OFF = 2048, XBC_OFF = 4096, Q_OFF = 7168, K_OFF = 8192, V_OFF = 9216;
constexpr int NSM = 48;
constexpr float EPS = 1e-6f;
constexpr int NPH = 9;
constexpr int WGU_TAIL_ITEMS = 1792;

constexpr size_t MiB = 1u << 20;
constexpr size_t WS_WIN = 0;
constexpr size_t WS_U = 45 * MiB;
constexpr size_t WS_STATES = 0;
constexpr size_t WS_H1G = 0;
constexpr size_t WS_WD = 32 * MiB;
constexpr size_t WS_WOUT = 77 * MiB;
constexpr size_t WS_PROJ = 93 * MiB;
constexpr size_t WS_CLOC = 269 * MiB;
constexpr size_t WS_SM = 333 * MiB;
constexpr size_t WS_MISC = 335 * MiB;
constexpr size_t WS_NLOC = WS_MISC;
constexpr size_t WS_BLAST = WS_MISC + 512 * 1024;
constexpr size_t WS_MLOC = WS_BLAST + 4096;
constexpr size_t WS_PM = WS_MLOC + 4096;
constexpr size_t WS_CDEC = WS_PM + 4096;
constexpr size_t WS_SS1 = WS_CDEC + 8192;
constexpr size_t WS_SS2 = WS_SS1 + 32768;
constexpr size_t WS_CNT = WS_SS2 + 32768;
constexpr size_t WS_PART1 = 336 * MiB;
constexpr size_t WS_PART2 = 337 * MiB;
constexpr size_t WS_BAR = 338 * MiB;
constexpr size_t WS_END = 339 * MiB;

constexpr int LDS_BYTES = 163840;

__device__ __forceinline__ unsigned cvt_pk_bf16(float lo, float hi) { unsigned r; asm volatile("v_cvt_pk_bf16_f32 %0, %1, %2" : "=v"(r) : "v"(lo), "v"(hi)); return r; }
__device__ __forceinline__ float bflo(unsigned u) { return __uint_as_float(u << 16); }
__device__ __forceinline__ float bfhi(unsigned u) { return __uint_as_float(u & 0xffff0000u); }
__device__ __forceinline__ bf16_t f2bf(float f) { return (bf16_t)(cvt_pk_bf16(f, 0.f) & 0xffffu); }
__device__ __forceinline__ float silu_f(float x) { return x * __builtin_amdgcn_rcpf(1.f + __expf(-x)); }
__device__ __forceinline__ float sigmoid_f(float x) { return __builtin_amdgcn_rcpf(1.f + __expf(-x)); }
__device__ __forceinline__ float softplus_f(float x) { return x > 20.f ? x : log1pf(expf(x)); }
__device__ __forceinline__ float logsigmoid_f(float x) { return fminf(x, 0.f) - log1pf(expf(-fabsf(x))); }
__device__ __forceinline__ float softcap_f(float x) { return 15.f * tanhf(x * (1.f / 15.f)); }
__device__ __forceinline__ float wave_scan_add(float v, int lane) {
#pragma unroll
    for (int o = 1; o < 64; o <<= 1) { const float t = __shfl_up(v, o); if (lane >= o) v += t; }
    return v;
}
__device__ __forceinline__ float wave_scan_max(float v, int lane) {
#pragma unroll
    for (int o = 1; o < 64; o <<= 1) { const float t = __shfl_up(v, o); if (lane >= o) v = fmaxf(v, t); }
    return v;
}
__device__ __forceinline__ float wave_max(float v) {
#pragma unroll
    for (int o = 1; o < 64; o <<= 1) v = fmaxf(v, __shfl_xor(v, o));
    return v;
}
__device__ __forceinline__ float wave_sum(float v) {
#pragma unroll
    for (int o = 1; o < 64; o <<= 1) v += __shfl_xor(v, o);
    return v;
}
#define LDS_WAIT() asm volatile("s_waitcnt lgkmcnt(0)" ::: "memory")
__device__ __forceinline__ float sload_f(const float* p, int idx) { float r; asm volatile("s_load_dword %0, %1, %2\n\ts_waitcnt lgkmcnt(0)" : "=s"(r) : "s"(p), "s"(idx * 4) : "memory"); return r; }

namespace pg8 {
#define PG8_LAS __attribute__((address_space(3)))
constexpr int BM = 256, BK = 64, HALF = 128, HTB = HALF * BK * 2, STAGE_BYTES = 8 * HTB, NXCD = 8, WGM = 8;
__host__ __device__ __forceinline__ int lds_byte(int r, int c) { const int st = (r >> 4) * 2 + (c >> 5), rr = r & 15, cc = c & 31, ob = rr * 64 + cc * 2; return st * 1024 + (ob ^ (((ob >> 9) & 1) << 5)); }
__host__ __device__ __forceinline__ void stage_rc(int b, int& R, int& C) { const int st = b / 1024, sb = b % 1024, swz = sb ^ (((sb >> 9) & 1) << 5); R = (st >> 1) * 16 + swz / 64; C = (st & 1) * 32 + (swz % 64) / 2; }
__host__ __device__ __forceinline__ int perm32(int rho) { const int n = rho >> 4, i = rho & 15; return 8 * (i >> 2) + 4 * n + (i & 3); }
struct Unit { int pm, pn; };
struct Gemm { const bf16_t* A; const bf16_t* Bt; int M, N, K, lda; };
struct StaticOrder {
    int nM, nN, nwg, G, c;
    __device__ void init(int M, int N, int G_, int c_) { nM = M / BM; nN = N / BM; nwg = nM * nN; G = G_; c = c_; }
    __device__ bool next(int i, Unit& u) const {
        const long Lx = (long)i * G + c; if (Lx >= nwg) return false;
        int wgid = (int)Lx; { const int q = nwg / NXCD, r = nwg % NXCD, xcd = wgid % NXCD, off = wgid / NXCD; wgid = (xcd < r ? xcd * (q + 1) : r * (q + 1) + (xcd - r) * q) + off; }
        const int nig = WGM * nN, gid = wgid / nig, fm = gid * WGM, gsz = (nM - fm) < WGM ? (nM - fm) : WGM;
        u.pm = fm + ((wgid % nig) % gsz); u.pn = (wgid % nig) / gsz; return true;
    }
};
template <class Epi>
__device__ __forceinline__ void gemm_phase(PG8_LAS unsigned char* lds, const Gemm g, const StaticOrder& S, const Epi& E, const int tid) {
    const int wid = __builtin_amdgcn_readfirstlane(tid >> 6), lane = tid & 63, wr = wid >> 2, wc = wid & 3, fr = lane & 15, fq = lane >> 4;
    const int K = g.K, nt = K / BK, lda = g.lda;
    unsigned voffA[2], voffB[2];
#pragma unroll
    for (int i = 0; i < 2; ++i) { int R, C; stage_rc(tid * 16 + i * 8192, R, C); const int Rb = Epi::PERM ? ((R & ~31) + perm32(R & 31)) : R;
        voffA[i] = (unsigned)(R * lda + C) * 2u; voffB[i] = (unsigned)(Rb * K + C) * 2u; }
    const size_t kstep = (size_t)(BK * 2);
    const size_t hstepA = (size_t)HALF * lda * 2, hstepB = (size_t)HALF * K * 2;
    const size_t tstepA = 2 * hstepA, tstepB = 2 * hstepB;
    const unsigned ldsw = (unsigned)wid * 1024u;
    const int aoff = lds_byte(wr * 64 + fr, fq * 8), boff = lds_byte(wc * 32 + fr, fq * 8);
#define PG8_SA(b, h) (((b) * 2 + (h)) * HTB)
#define PG8_SB(b, h) ((4 + (b) * 2 + (h)) * HTB)
#define PG8_STAGE(bufoff, gbase, voff) do { _Pragma("unroll") for (int _i = 0; _i < 2; ++_i) \
        __builtin_amdgcn_global_load_lds((const unsigned*)((const char*)(gbase) + (voff)[_i]), (PG8_LAS unsigned*)(lds + (bufoff) + ldsw + _i * 8192), 16, 0, 0); } while (0)
#define PG8_LDA(dst, b, h) do { _Pragma("unroll") for (int m = 0; m < 4; ++m) _Pragma("unroll") for (int k = 0; k < 2; ++k) dst[m][k] = *(const PG8_LAS bf16x8*)(lds + PG8_SA(b, h) + aoff + m * 2048 + k * 1024); } while (0)
#define PG8_LDB(dst, b, h) do { _Pragma("unroll") for (int n = 0; n < 2; ++n) _Pragma("unroll") for (int k = 0; k < 2; ++k) dst[n][k] = *(const PG8_LAS bf16x8*)(lds + PG8_SB(b, h) + boff + n * 2048 + k * 1024); } while (0)
#define PG8_MMA(ai, bj, At, Bt) do { __builtin_amdgcn_s_setprio(1); _Pragma("unroll") for (int m = 0; m < 4; ++m) _Pragma("unroll") for (int n = 0; n < 2; ++n) _Pragma("unroll") for (int k = 0; k < 2; ++k) \
        acc[ai][bj][m][n] = __builtin_amdgcn_mfma_f32_16x16x32_bf16(Bt[n][k], At[m][k], acc[ai][bj][m][n], 0, 0, 0); __builtin_amdgcn_s_setprio(0); } while (0)
#define PG8_WAIT_V(n) asm volatile("s_waitcnt vmcnt(" #n ")" ::: "memory")
#define PG8_WAIT_L(n) asm volatile("s_waitcnt lgkmcnt(" #n ")" ::: "memory")
#define PG8_BAR __builtin_amdgcn_s_barrier()
#define PG8_SCHED __builtin_amdgcn_sched_barrier(0)
    Unit cur, nxt; int ui = 0;
    if (!S.next(0, cur)) return;
    f32x4 acc[2][2][4][2];
#pragma unroll
    for (int a = 0; a < 2; ++a)
#pragma unroll
        for (int b = 0; b < 2; ++b)
#pragma unroll
            for (int m = 0; m < 4; ++m)
#pragma unroll
                for (int n = 0; n < 2; ++n) acc[a][b][m][n] = (f32x4){0.f, 0.f, 0.f, 0.f};
    bf16x8 At[4][2], B0[2][2], B1[2][2];
    const char* cA = (const char*)g.A + (size_t)cur.pm * tstepA; const char* cB = (const char*)g.Bt + (size_t)cur.pn * tstepB;
    PG8_STAGE(PG8_SB(0, 0), cB, voffB); PG8_STAGE(PG8_SA(0, 0), cA, voffA); PG8_STAGE(PG8_SB(0, 1), cB + hstepB, voffB); PG8_STAGE(PG8_SA(0, 1), cA + hstepA, voffA);
    if (wr == 1) PG8_BAR;
    PG8_WAIT_V(4); PG8_BAR;
    PG8_STAGE(PG8_SB(1, 0), cB + kstep, voffB); PG8_STAGE(PG8_SA(1, 0), cA + kstep, voffA); PG8_STAGE(PG8_SB(1, 1), cB + hstepB + kstep, voffB);
    PG8_WAIT_V(6); PG8_BAR;
    for (;;) {
        const bool has_next = S.next(ui + 1, nxt);
        const char* nA = has_next ? (const char*)g.A + (size_t)nxt.pm * tstepA : cA; const char* nB = has_next ? (const char*)g.Bt + (size_t)nxt.pn * tstepB : cB;
        for (int t = 0; t < nt; t += 2) {
            const bool last = (t == nt - 2);
            const char* a1 = cA + (size_t)(t + 1) * kstep;
            const char* a2 = last ? nA : cA + (size_t)(t + 2) * kstep; const char* b2 = last ? nB : cB + (size_t)(t + 2) * kstep;
            const char* a3 = a2 + kstep; const char* b3 = b2 + kstep;
            PG8_LDB(B0, 0, 0); PG8_SCHED; PG8_LDA(At, 0, 0); PG8_STAGE(PG8_SA(1, 1), a1 + hstepA, voffA);
            PG8_WAIT_L(8); PG8_BAR; PG8_WAIT_L(0); PG8_MMA(0, 0, At, B0); PG8_BAR; PG8_SCHED;
            PG8_LDB(B1, 0, 1); PG8_STAGE(PG8_SB(0, 0), b2, voffB);
            PG8_BAR; PG8_WAIT_L(0); PG8_MMA(0, 1, At, B1); PG8_BAR;
            PG8_LDA(At, 0, 1); PG8_STAGE(PG8_SA(0, 0), a2, voffA);
            PG8_BAR; PG8_WAIT_L(0); PG8_MMA(1, 0, At, B0); PG8_BAR; PG8_SCHED;
            PG8_STAGE(PG8_SB(0, 1), b2 + hstepB, voffB);
            PG8_WAIT_V(6); PG8_BAR; PG8_MMA(1, 1, At, B1); PG8_BAR;
            PG8_LDB(B0, 1, 0); PG8_SCHED; PG8_LDA(At, 1, 0); PG8_STAGE(PG8_SA(0, 1), a2 + hstepA, voffA);
            PG8_WAIT_L(8); PG8_BAR; PG8_WAIT_L(0); PG8_MMA(0, 0, At, B0); PG8_BAR; PG8_SCHED;
            PG8_LDB(B1, 1, 1); PG8_STAGE(PG8_SB(1, 0), b3, voffB);
            PG8_BAR; PG8_WAIT_L(0); PG8_MMA(0, 1, At, B1); PG8_BAR;
            PG8_LDA(At, 1, 1); PG8_STAGE(PG8_SA(1, 0), a3, voffA);
            PG8_BAR; PG8_WAIT_L(0); PG8_MMA(1, 0, At, B0); PG8_BAR; PG8_SCHED;
            PG8_STAGE(PG8_SB(1, 1), b3 + hstepB, voffB);
            PG8_WAIT_V(6); PG8_BAR; PG8_MMA(1, 1, At, B1); PG8_BAR;
        }
        if constexpr (!Epi::AFTER_DRAIN) E(acc, cur, wr, wc, fr, fq);
        if (!has_next) break;
#pragma unroll
        for (int a = 0; a < 2; ++a)
#pragma unroll
            for (int b = 0; b < 2; ++b)
#pragma unroll
                for (int m = 0; m < 4; ++m)
#pragma unroll
                    for (int n = 0; n < 2; ++n) acc[a][b][m][n] = (f32x4){0.f, 0.f, 0.f, 0.f};
        cur = nxt; cA = nA; cB = nB; ++ui;
    }
    PG8_WAIT_V(0);
    if (wr == 0) PG8_BAR;
    PG8_BAR;
    if constexpr (Epi::AFTER_DRAIN) E(acc, cur, wr, wc, fr, fq);
#undef PG8_SA
#undef PG8_SB
#undef PG8_STAGE
#undef PG8_LDA
#undef PG8_LDB
#undef PG8_MMA
#undef PG8_WAIT_V
#undef PG8_WAIT_L
#undef PG8_BAR
#undef PG8_SCHED
}
}
using pg8::Unit;

struct EpiProj {
    static constexpr bool PERM = true, AFTER_DRAIN = false;
    bf16_t* O; float* SM;
    __device__ __forceinline__ void operator()(const f32x4 (&acc)[2][2][4][2], const Unit& u, int wr, int wc, int fr, int fq) const {
        const int row0 = u.pm * 256 + wr * 64 + fr;
        if (u.pn < 44) {
            const int col0 = u.pn * 256 + wc * 32 + 8 * fq;
#pragma unroll
            for (int ai = 0; ai < 2; ++ai)
#pragma unroll
                for (int m = 0; m < 4; ++m) { bf16_t* rowp = O + (size_t)(row0 + ai * 128 + m * 16) * NPROJ + col0;
#pragma unroll
                    for (int bj = 0; bj < 2; ++bj) { const f32x4 v0 = acc[ai][bj][m][0], v1 = acc[ai][bj][m][1];
                        u32x4 w; w.x = cvt_pk_bf16(v0[0], v0[1]); w.y = cvt_pk_bf16(v0[2], v0[3]); w.z = cvt_pk_bf16(v1[0], v1[1]); w.w = cvt_pk_bf16(v1[2], v1[3]);
                        *(u32x4*)(rowp + bj * 128) = w; } }
        } else {
            if (wc < 2) {
#pragma unroll
                for (int ai = 0; ai < 2; ++ai)
#pragma unroll
                    for (int m = 0; m < 4; ++m) { float* rowp = SM + (size_t)(row0 + ai * 128 + m * 16) * NSM;
#pragma unroll
                        for (int n = 0; n < 2; ++n) { const int c = wc * 32 + 8 * fq + 4 * n; if (c < NSM) *(f32x4*)(rowp + c) = acc[ai][0][m][n]; } }
            }
        }
    }
};
struct EpiOut {
    static constexpr bool PERM = false, AFTER_DRAIN = false;
    const float* x; float* h1; bf16_t* h1g; const float* g; float* ss;
    __device__ __forceinline__ void operator()(const f32x4 (&acc)[2][2][4][2], const Unit& u, int wr, int wc, int fr, int fq) const {
        const int row0 = u.pm * 256 + wr * 64 + fr, col0 = u.pn * 256 + wc * 32 + 4 * fq;
#pragma unroll
        for (int ai = 0; ai < 2; ++ai)
#pragma unroll
            for (int m = 0; m < 4; ++m) { const int row = row0 + ai * 128 + m * 16; const size_t off = (size_t)row * DM + col0; float s = 0.f;
#pragma unroll
                for (int bj = 0; bj < 2; ++bj)
#pragma unroll
                    for (int n = 0; n < 2; ++n) { const int co = bj * 128 + n * 16; const f32x4 xv = *(const f32x4*)(x + off + co); const f32x4 h = xv + acc[ai][bj][m][n];
                        *(f32x4*)(h1 + off + co) = h; s += (h[0] * h[0] + h[1] * h[1]) + (h[2] * h[2] + h[3] * h[3]);
                        const f32x4 gv = *(const f32x4*)(g + col0 + co); u32x2 w; w.x = cvt_pk_bf16(h[0] * gv[0], h[1] * gv[1]); w.y = cvt_pk_bf16(h[2] * gv[2], h[3] * gv[3]);
                        *(u32x2*)(h1g + off + co) = w; }
                s += __shfl_xor(s, 16); s += __shfl_xor(s, 32);
                if (fq == 0) atomicAdd(ss + row, s); }
    }
};
template <bool DET> struct EpiGUT {
    static constexpr bool PERM = true, AFTER_DRAIN = false;
    bf16_t* act; const float* ss;
    __device__ __forceinline__ void operator()(const f32x4 (&acc)[2][2][4][2], const Unit& u, int wr, int wc, int fr, int fq) const {
        const int row0 = u.pm * 256 + wr * 64 + fr, f0 = u.pn * 128 + wc * 32 + 8 * fq;
#pragma unroll
        for (int ai = 0; ai < 2; ++ai)
#pragma unroll
            for (int m = 0; m < 4; ++m) { const int row = row0 + ai * 128 + m * 16; const float r = DET ? ss[row] : __builtin_amdgcn_rsqf(ss[row] * (1.f / DM) + EPS);
                float a[8];
#pragma unroll
                for (int n = 0; n < 2; ++n)
#pragma unroll
                    for (int j = 0; j < 4; ++j) { const float gg = acc[ai][0][m][n][j] * r, uu = acc[ai][1][m][n][j] * r; a[4 * n + j] = silu_f(gg) * uu; }
                u32x4 w; w.x = cvt_pk_bf16(a[0], a[1]); w.y = cvt_pk_bf16(a[2], a[3]); w.z = cvt_pk_bf16(a[4], a[5]); w.w = cvt_pk_bf16(a[6], a[7]);
                *(u32x4*)(act + (size_t)row * DFF + f0) = w; }
    }
};
struct EpiDown {
    static constexpr bool PERM = false, AFTER_DRAIN = false;
    const float* hin; float* h; float* ss;
    __device__ __forceinline__ void operator()(const f32x4 (&acc)[2][2][4][2], const Unit& u, int wr, int wc, int fr, int fq) const {
        const int row0 = u.pm * 256 + wr * 64 + fr, col0 = u.pn * 256 + wc * 32 + 4 * fq;
#pragma unroll
        for (int ai = 0; ai < 2; ++ai)
#pragma unroll
            for (int m = 0; m < 4; ++m) { const int row = row0 + ai * 128 + m * 16; const size_t off = (size_t)row * DM + col0; float s = 0.f;
#pragma unroll
                for (int bj = 0; bj < 2; ++bj)
#pragma unroll
                    for (int n = 0; n < 2; ++n) { const int co = bj * 128 + n * 16; const f32x4 hv = *(const f32x4*)(hin + off + co) + acc[ai][bj][m][n];
                        *(f32x4*)(h + off + co) = hv; s += (hv[0] * hv[0] + hv[1] * hv[1]) + (hv[2] * hv[2] + hv[3] * hv[3]); }
                s += __shfl_xor(s, 16); s += __shfl_xor(s, 32);
                if (fq == 0) atomicAdd(ss + row, s); }
    }
};

struct EpiDownFused {
    static constexpr bool PERM = false, AFTER_DRAIN = true;
    const float* hin; float* h; float* ss; unsigned* cnt; const float* g;
    __device__ __forceinline__ void operator()(f32x4 (&acc)[2][2][4][2], const Unit& u, int wr, int wc, int fr, int fq) const {
        const int row0 = u.pm * 256 + wr * 64 + fr, col0 = u.pn * 256 + wc * 32 + 4 * fq;
        float keep = 0.f;
#pragma unroll
        for (int ai = 0; ai < 2; ++ai)
#pragma unroll
            for (int m = 0; m < 4; ++m) { const int row = row0 + ai * 128 + m * 16; const size_t off = (size_t)row * DM + col0; float sq = 0.f;
#pragma unroll
                for (int bj = 0; bj < 2; ++bj)
#pragma unroll
                    for (int n = 0; n < 2; ++n) { const int co = bj * 128 + n * 16; const f32x4 hv = *(const f32x4*)(hin + off + co) + acc[ai][bj][m][n];
                        acc[ai][bj][m][n] = hv; sq += (hv[0] * hv[0] + hv[1] * hv[1]) + (hv[2] * hv[2] + hv[3] * hv[3]); }
                sq += __shfl_xor(sq, 16); sq += __shfl_xor(sq, 32);
                if (fq == 0) keep += __hip_atomic_fetch_add(ss + row, sq, __ATOMIC_RELAXED, __HIP_MEMORY_SCOPE_AGENT); }
        asm volatile("s_waitcnt vmcnt(0)" :: "v"(keep) : "memory");
        if ((threadIdx.x & 63) == 0) __hip_atomic_fetch_add(cnt + 64 * u.pm, 1u, __ATOMIC_RELAXED, __HIP_MEMORY_SCOPE_AGENT);
        if (threadIdx.x == 0) { unsigned spins = 0;
            while (__hip_atomic_load(cnt + 64 * u.pm, __ATOMIC_RELAXED, __HIP_MEMORY_SCOPE_AGENT) < 64u && ++spins < (1u << 22)) __builtin_amdgcn_s_sleep(2); }
        __syncthreads();
#pragma unroll
        for (int ai = 0; ai < 2; ++ai)
#pragma unroll
            for (int m = 0; m < 4; ++m) { const int row = row0 + ai * 128 + m * 16; const size_t off = (size_t)row * DM + col0;
                const float tot = __hip_atomic_load(ss + row, __ATOMIC_RELAXED, __HIP_MEMORY_SCOPE_AGENT); const float r = __builtin_amdgcn_rsqf(tot * (1.f / DM) + EPS);
#pragma unroll
                for (int bj = 0; bj < 2; ++bj)
#pragma unroll
                    for (int n = 0; n < 2; ++n) { const int co = bj * 128 + n * 16; const f32x4 gv = *(const f32x4*)(g + col0 + co);
                        *(f32x4*)(h + off + co) = acc[ai][bj][m][n] * r * gv; } }
    }
};

__device__ __forceinline__ float row_total(const float* part, int row) {
    float t = 0.f;
#pragma unroll
    for (int k = 0; k < 32; ++k) t += __hip_atomic_load(part + (size_t)row * 32 + k, __ATOMIC_RELAXED, __HIP_MEMORY_SCOPE_AGENT);
    return t;
}
struct EpiOutDet {
    static constexpr bool PERM = false, AFTER_DRAIN = true;
    const float* x; float* h1; bf16_t* h1g; const float* g; float* part; unsigned* cnt; float* rstd;
    __device__ __forceinline__ void operator()(f32x4 (&acc)[2][2][4][2], const Unit& u, int wr, int wc, int fr, int fq) const {
        const int row0 = u.pm * 256 + wr * 64 + fr, col0 = u.pn * 256 + wc * 32 + 4 * fq;
#pragma unroll
        for (int ai = 0; ai < 2; ++ai)
#pragma unroll
            for (int m = 0; m < 4; ++m) { const int row = row0 + ai * 128 + m * 16; const size_t off = (size_t)row * DM + col0; float sq = 0.f;
#pragma unroll
                for (int bj = 0; bj < 2; ++bj)
#pragma unroll
                    for (int n = 0; n < 2; ++n) { const int co = bj * 128 + n * 16; const f32x4 xv = *(const f32x4*)(x + off + co); const f32x4 h = xv + acc[ai][bj][m][n];
                        *(f32x4*)(h1 + off + co) = h; sq += (h[0] * h[0] + h[1] * h[1]) + (h[2] * h[2] + h[3] * h[3]);
                        const f32x4 gv = *(const f32x4*)(g + col0 + co); u32x2 w; w.x = cvt_pk_bf16(h[0] * gv[0], h[1] * gv[1]); w.y = cvt_pk_bf16(h[2] * gv[2], h[3] * gv[3]);
                        *(u32x2*)(h1g + off + co) = w; }
                sq += __shfl_xor(sq, 16); sq += __shfl_xor(sq, 32);
                if (fq == 0) __hip_atomic_store(part + (size_t)row * 32 + u.pn * 4 + wc, sq, __ATOMIC_RELAXED, __HIP_MEMORY_SCOPE_AGENT); }
        asm volatile("s_waitcnt vmcnt(0)" ::: "memory");
        unsigned old = 0u;
        if (fr == 0 && fq == 0) old = __hip_atomic_fetch_add(cnt + 64 * u.pm, 1u, __ATOMIC_RELAXED, __HIP_MEMORY_SCOPE_AGENT);
        old = (unsigned)__builtin_amdgcn_readfirstlane((int)old);
        if (old == 63u) {
            const int lane = fq * 16 + fr;
#pragma unroll
            for (int rr = 0; rr < 4; ++rr) { const int row = u.pm * 256 + lane * 4 + rr; rstd[row] = __builtin_amdgcn_rsqf(row_total(part, row) * (1.f / DM) + EPS); }
        }
    }
};
struct EpiDownDet {
    static constexpr bool PERM = false, AFTER_DRAIN = true;
    const float* hin; float* h; float* part; unsigned* cnt; const float* g; LAS float* sR;
    __device__ __forceinline__ void operator()(f32x4 (&acc)[2][2][4][2], const Unit& u, int wr, int wc, int fr, int fq) const {
        const int row0 = u.pm * 256 + wr * 64 + fr, col0 = u.pn * 256 + wc * 32 + 4 * fq;
#pragma unroll
        for (int ai = 0; ai < 2; ++ai)
#pragma unroll
            for (int m = 0; m < 4; ++m) { const int row = row0 + ai * 128 + m * 16; const size_t off = (size_t)row * DM + col0; float sq = 0.f;
#pragma unroll
                for (int bj = 0; bj < 2; ++bj)
#pragma unroll
                    for (int n = 0; n < 2; ++n) { const int co = bj * 128 + n * 16; const f32x4 hv = *(const f32x4*)(hin + off + co) + acc[ai][bj][m][n];
                        acc[ai][bj][m][n] = hv; sq += (hv[0] * hv[0] + hv[1] * hv[1]) + (hv[2] * hv[2] + hv[3] * hv[3]); }
                sq += __shfl_xor(sq, 16); sq += __shfl_xor(sq, 32);
                if (fq == 0) __hip_atomic_store(part + (size_t)row * 32 + u.pn * 4 + wc, sq, __ATOMIC_RELAXED, __HIP_MEMORY_SCOPE_AGENT); }
        asm volatile("s_waitcnt vmcnt(0)" ::: "memory");
        if (fr == 0 && fq == 0) __hip_atomic_fetch_add(cnt + 64 * u.pm, 1u, __ATOMIC_RELAXED, __HIP_MEMORY_SCOPE_AGENT);
        if (fr == 0 && fq == 0 && wr == 0 && wc == 0) { unsigned spins = 0;
            while (__hip_atomic_load(cnt + 64 * u.pm, __ATOMIC_RELAXED, __HIP_MEMORY_SCOPE_AGENT) < 64u && ++spins < (1u << 22)) __builtin_amdgcn_s_sleep(2); }
        __syncthreads();
        const int tid = (wr * 4 + wc) * 64 + fq * 16 + fr;
        if (tid < 256) sR[tid] = __builtin_amdgcn_rsqf(row_total(part, u.pm * 256 + tid) * (1.f / DM) + EPS);
        __syncthreads();
#pragma unroll
        for (int ai = 0; ai < 2; ++ai)
#pragma unroll
            for (int m = 0; m < 4; ++m) { const int rl = wr * 64 + fr + ai * 128 + m * 16; const size_t off = (size_t)(u.pm * 256 + rl) * DM + col0; const float r = sR[rl];
#pragma unroll
                for (int bj = 0; bj < 2; ++bj)
#pragma unroll
                    for (int n = 0; n < 2; ++n) { const int co = bj * 128 + n * 16; const f32x4 gv = *(const f32x4*)(g + col0 + co);
                        *(f32x4*)(h + off + co) = acc[ai][bj][m][n] * r * gv; } }
    }
};

struct Params {
    const float *x, *norm_mix_g, *w_in, *conv_w, *conv_b, *dt_bias, *a_log, *d_skip, *ssd_norm_g, *i_bias, *f_bias, *mlstm_norm_g, *w_out, *norm_ffn_g, *w_gate, *w_up, *w_down, *final_norm_g;
    float* out; unsigned char* ws; int ph_lo, ph_hi;
};

__device__ __forceinline__ void ti_load(const float* __restrict__ colp, int ldw, int k0, int lane, f32x4 (&v)[16]) {
    const int kq = lane >> 4;
#pragma unroll
    for (int i = 0; i < 16; ++i) v[i] = colp ? __builtin_nontemporal_load((const f32x4*)(colp + (size_t)(k0 + 4 * i + kq) * ldw)) : (f32x4){0.f, 0.f, 0.f, 0.f};
}
__device__ __forceinline__ void ti_to_lds(const f32x4 (&v)[16], LAS float* scr, int lane) {
    const int n4 = (lane & 15) * 4, kq = lane >> 4;
#pragma unroll
    for (int i = 0; i < 16; ++i) { LAS float* d = scr + (4 * i + kq) * 65 + n4; d[0] = v[i][0]; d[1] = v[i][1]; d[2] = v[i][2]; d[3] = v[i][3]; }
}
__device__ __forceinline__ void ti_store(bf16_t* WT, int ldt, int dstrow0, int k0, LAS float* scr, int lane) {
    LDS_WAIT();
    const int c8 = lane & 7;
#pragma unroll
    for (int j = 0; j < 8; ++j) { const int n = (lane >> 3) + 8 * j; const LAS float* sp = scr + (8 * c8) * 65 + n;
        u32x4 o; o.x = cvt_pk_bf16(sp[0 * 65], sp[1 * 65]); o.y = cvt_pk_bf16(sp[2 * 65], sp[3 * 65]); o.z = cvt_pk_bf16(sp[4 * 65], sp[5 * 65]); o.w = cvt_pk_bf16(sp[6 * 65], sp[7 * 65]);
        *(u32x4*)(WT + (size_t)(dstrow0 + n) * ldt + k0 + 8 * c8) = o; }
    LDS_WAIT();
}
struct TItem { const float* colp; int ldw, k0; bf16_t* WT; int ldt, dstrow0; };
__device__ __forceinline__ int win_src_col(int j) {
    if (j < 2048) return j;
    if (j < 4096) return 9248 + (j - 2048);
    if (j < 7168) return 2048 + (j - 4096);
    if (j < 8192) return 5152 + (j - 7168);
    if (j < 9216) return 6176 + (j - 8192);
    if (j < 11264) return 7200 + (j - 9216);
    if (j < 11296) return 5120 + (j - 11264);
    return j;
}

__device__ __forceinline__ TItem titem(const Params& p, unsigned char* ws, int which, int it, int lane) {
    TItem t; const int n4 = (lane & 15) * 4;
    if (which == 0) { const int kb = it / 180, nb = it % 180, j = 64 * nb + n4; t.colp = j < NIN_SRC ? p.w_in + win_src_col(j & ~31) + (j & 31) : nullptr; t.ldw = NIN_SRC; t.k0 = 64 * kb; t.WT = (bf16_t*)(ws + WS_WIN); t.ldt = DM; t.dstrow0 = 64 * nb; }
    else if (which == 1) { const int kb = it / 32, nb = it % 32; t.colp = p.w_out + 64 * nb + n4; t.ldw = DM; t.k0 = 64 * kb; t.WT = (bf16_t*)(ws + WS_WOUT); t.ldt = 4096; t.dstrow0 = 64 * nb; }
    else if (which == 2) { const int kb = it / 176, nb = it % 176, n0 = 64 * nb, pn = n0 >> 8, bj = (n0 >> 7) & 1, i0 = n0 & 127; t.colp = (bj ? p.w_up : p.w_gate) + pn * 128 + i0 + n4; t.ldw = DFF; t.k0 = 64 * kb; t.WT = (bf16_t*)p.out; t.ldt = DM; t.dstrow0 = n0; }
    else { const int kb = it / 32, nb = it % 32; t.colp = p.w_down + 64 * nb + n4; t.ldw = DM; t.k0 = 64 * kb; t.WT = (bf16_t*)(ws + WS_WD); t.ldt = DFF; t.dstrow0 = 64 * nb; }
    return t;
}
__device__ __forceinline__ void convert_items(const Params& p, unsigned char* ws, int which, int first, int nitems, int step, LAS float* scr, int lane) {
    if (first >= nitems) return;
    f32x4 v[16]; TItem cur = titem(p, ws, which, first, lane); ti_load(cur.colp, cur.ldw, cur.k0, lane, v);
    for (int it = first; it < nitems; it += step) {
        ti_to_lds(v, scr, lane);
        TItem nxt = cur; const bool has = it + step < nitems;
        if (has) { nxt = titem(p, ws, which, it + step, lane); ti_load(nxt.colp, nxt.ldw, nxt.k0, lane, v); }
        ti_store(cur.WT, cur.ldt, cur.dstrow0, cur.k0, scr, lane);
        cur = nxt;
    }
}

__device__ __forceinline__ void conv8(const bf16_t* proj, const float* __restrict__ cw, const float* __restrict__ cb, int t, int ch0, float (&o)[8]) {
    const f32x4 b0 = *(const f32x4*)(cb + ch0), b1 = *(const f32x4*)(cb + ch0 + 4);
    float a[8] = {b0[0], b0[1], b0[2], b0[3], b1[0], b1[1], b1[2], b1[3]};
#pragma unroll
    for (int tap = 0; tap < 4; ++tap) { const int tt = t - 3 + tap;
        if (tt >= 0) { const u32x4 r = *(const u32x4*)(proj + (size_t)tt * NPROJ + XBC_OFF + ch0);
            const f32x4 w0 = *(const f32x4*)(cw + tap * 3072 + ch0), w1 = *(const f32x4*)(cw + tap * 3072 + ch0 + 4);
            a[0] += w0[0] * bflo(r.x); a[1] += w0[1] * bfhi(r.x); a[2] += w0[2] * bflo(r.y); a[3] += w0[3] * bfhi(r.y);
            a[4] += w1[0] * bflo(r.z); a[5] += w1[1] * bfhi(r.z); a[6] += w1[2] * bflo(r.w); a[7] += w1[3] * bfhi(r.w); } }
#pragma unroll
    for (int e = 0; e < 8; ++e) o[e] = silu_f(a[e]);
}
__device__ __forceinline__ u32x4 pack8(const float (&o)[8]) { u32x4 w; w.x = cvt_pk_bf16(o[0], o[1]); w.y = cvt_pk_bf16(o[2], o[3]); w.z = cvt_pk_bf16(o[4], o[5]); w.w = cvt_pk_bf16(o[6], o[7]); return w; }
struct ConvW { f32x4 w[4][2]; f32x4 b[2]; };
__device__ __forceinline__ void convw_load(const float* __restrict__ cw, const float* __restrict__ cb, int ch0, ConvW& W) {
    W.b[0] = *(const f32x4*)(cb + ch0); W.b[1] = *(const f32x4*)(cb + ch0 + 4);
#pragma unroll
    for (int tap = 0; tap < 4; ++tap) { W.w[tap][0] = *(const f32x4*)(cw + tap * 3072 + ch0); W.w[tap][1] = *(const f32x4*)(cw + tap * 3072 + ch0 + 4); }
}
template <int R> __device__ __forceinline__ void conv_load(const bf16_t* proj, int t, int ch0, u32x4 (&raw)[R + 3]) {
#pragma unroll
    for (int j = 0; j < R + 3; ++j) { const int tt = t - 3 + j; raw[j] = tt >= 0 ? *(const u32x4*)(proj + (size_t)tt * NPROJ + XBC_OFF + ch0) : (u32x4){0u, 0u, 0u, 0u}; }
}
template <int R> __device__ __forceinline__ void conv_row(const u32x4 (&raw)[R + 3], const ConvW& W, int r, float (&o)[8]) {
    float a[8] = {W.b[0][0], W.b[0][1], W.b[0][2], W.b[0][3], W.b[1][0], W.b[1][1], W.b[1][2], W.b[1][3]};
#pragma unroll
    for (int tap = 0; tap < 4; ++tap) { const u32x4 x = raw[r + tap];
        a[0] += W.w[tap][0][0] * bflo(x.x); a[1] += W.w[tap][0][1] * bfhi(x.x); a[2] += W.w[tap][0][2] * bflo(x.y); a[3] += W.w[tap][0][3] * bfhi(x.y);
        a[4] += W.w[tap][1][0] * bflo(x.z); a[5] += W.w[tap][1][1] * bfhi(x.z); a[6] += W.w[tap][1][2] * bflo(x.w); a[7] += W.w[tap][1][3] * bfhi(x.w); }
#pragma unroll
    for (int e = 0; e < 8; ++e) o[e] = silu_f(a[e]);
}

__device__ __forceinline__ void ssd_gates(const Params& p, const float* SM, int c, int g, LAS float* sDt, LAS float* sAc, int wid, int lane) {
    const int h = 8 * g + wid; const float A = -expf(sload_f(p.a_log, h)), bias = sload_f(p.dt_bias, h);
    float carry = 0.f;
#pragma unroll
    for (int half = 0; half < 2; ++half) { const int l = half * 64 + lane; const int t = c * 128 + l;
        const float dt = softplus_f(SM[(size_t)t * NSM + h] + bias); const float sc = wave_scan_add(dt * A, lane) + carry;
        sDt[wid * 128 + l] = dt; sAc[wid * 128 + l] = sc; carry = __shfl(sc, 63); }
}
#define MFMA16(a, b, c) __builtin_amdgcn_mfma_f32_16x16x32_bf16((a), (b), (c), 0, 0, 0)
#define LDFRAG(base, row, pitch, kel) (*(const LAS bf16x8*)((base) + (size_t)(row) * (pitch) + (kel)))

#define XB_TMO      128
#define XB_XCNT(j)  (256  + 64 * (j))
#define XB_XSUB(j)  (1280 + 64 * (j))
#define XB_XGEN(j)  (2304 + 64 * (j))
#define XB_TOP      3328
#define XB_TOPGEN   3392
#define XCD_BAR_WORDS 3456
#define XB_SPIN_CAP (1u << 18)
__device__ __forceinline__ unsigned xb_ld(unsigned* p)              { return __hip_atomic_load(p, __ATOMIC_RELAXED, __HIP_MEMORY_SCOPE_AGENT); }
__device__ __forceinline__ unsigned xb_add(unsigned* p, unsigned v) { return __hip_atomic_fetch_add(p, v, __ATOMIC_RELAXED, __HIP_MEMORY_SCOPE_AGENT); }
__device__ __forceinline__ unsigned xb_xcc_id() { return (unsigned)__builtin_amdgcn_s_getreg((3 << 11) | 20) & 0xFu; }
#define XB_SPIN(cond, bar) do { unsigned _sp = 0; while (cond) { __builtin_amdgcn_s_sleep(1); \
    if ((++_sp & 255u) == 0u) { if (xb_ld(&(bar)[XB_TMO])) break; if (_sp > XB_SPIN_CAP) { atomicAdd(&(bar)[XB_TMO], 1u); break; } } } } while (0)
struct XcdBarrier { unsigned* bar; unsigned x; volatile LAS unsigned* st; };
__device__ __forceinline__ void xcd_barrier_complete(unsigned* bar, unsigned x, unsigned& nloc, unsigned& nx) {
    const unsigned G = gridDim.x * gridDim.y * gridDim.z;
    unsigned sum, cnt, mine, sp = 0u;
    for (;;) {
        sum = 0u; cnt = 0u; mine = 0u;
#pragma unroll
        for (unsigned j = 0; j < 16; ++j) { const unsigned c = xb_ld(&bar[XB_XCNT(j)]); sum += c; cnt += (c > 0u) ? 1u : 0u; mine = (j == x) ? c : mine; }
        if (sum == G) break;
        __builtin_amdgcn_s_sleep(1);
        if ((++sp & 255u) == 0u) { if (xb_ld(&bar[XB_TMO])) break; if (sp > XB_SPIN_CAP) { atomicAdd(&bar[XB_TMO], 1u); break; } }
    }
    nloc = mine > 0u ? mine : 1u; nx = cnt > 0u ? cnt : 1u;
}
__device__ __forceinline__ void xcd_barrier(const XcdBarrier& b, const bool lead) {
    asm volatile("s_waitcnt vmcnt(0)" ::: "memory");
    __syncthreads();
    if (lead) {
        unsigned* bar = b.bar;
        __builtin_amdgcn_s_waitcnt(0);
        unsigned nloc = b.st[0], nx = b.st[1];
        if (nloc == 0u) { xcd_barrier_complete(bar, b.x, nloc, nx); b.st[0] = nloc; b.st[1] = nx; }
        const unsigned old = xb_add(&bar[XB_XSUB(b.x)], 1u);
        const unsigned gen = old / nloc;
        if (old + 1u == (gen + 1u) * nloc) {
            __builtin_amdgcn_fence(__ATOMIC_RELEASE, "agent");
            asm volatile("s_waitcnt vmcnt(0)" ::: "memory");
            const unsigned og = xb_add(&bar[XB_TOP], 1u);
            const unsigned tg = og / nx;
            if (og + 1u == (tg + 1u) * nx) xb_add(&bar[XB_TOPGEN], 1u);
            else XB_SPIN(xb_ld(&bar[XB_TOPGEN]) == tg, bar);
            __builtin_amdgcn_fence(__ATOMIC_ACQUIRE, "agent");
            xb_add(&bar[XB_XGEN(b.x)], 1u);
            asm volatile("s_waitcnt vmcnt(0)" ::: "memory");
        } else {
            XB_SPIN(xb_ld(&bar[XB_XGEN(b.x)]) == gen, bar);
            __builtin_amdgcn_fence(__ATOMIC_ACQUIRE, "agent");
            asm volatile("s_waitcnt vmcnt(0)" ::: "memory");
        }
    }
    __syncthreads();
}

__device__ __forceinline__ void p2_ssd(const Params& p, LAS unsigned char* lds, const int bid, const int G, const int tid, const int lane, const int wid) {
    unsigned char* ws = p.ws;
    bf16_t* STATES = (bf16_t*)(ws + WS_STATES); bf16_t* PROJ = (bf16_t*)(ws + WS_PROJ); bf16_t* CLOC = (bf16_t*)(ws + WS_CLOC);
    float* SM = (float*)(ws + WS_SM); float* NLOC = (float*)(ws + WS_NLOC); float* BLAST = (float*)(ws + WS_BLAST); float* MLOC = (float*)(ws + WS_MLOC);
    float* PM = (float*)(ws + WS_PM); float* CDEC = (float*)(ws + WS_CDEC);
    (void)STATES; (void)PROJ; (void)CLOC; (void)SM; (void)NLOC; (void)BLAST; (void)MLOC; (void)PM; (void)CDEC;
        {
            LAS bf16_t* sBT = (LAS bf16_t*)(lds); LAS bf16_t* sXT = (LAS bf16_t*)(lds + 34816);
            LAS float* sDt = (LAS float*)(lds + 69632); LAS float* sAc = (LAS float*)(lds + 73728);
            LAS bf16_t* sOutS = (LAS bf16_t*)(lds + 77824);
            for (int unit = bid; unit < 256; unit += G) { const int c = unit >> 2, g = unit & 3, t0 = c * 128;
                const int rb = tid >> 4, ng = tid & 15;
                u32x4 rawB[7]; conv_load<4>(PROJ, t0 + rb * 4, 2048 + g * 128 + ng * 8, rawB);
                __syncthreads();
                ssd_gates(p, SM, c, g, sDt, sAc, wid, lane);
                { ConvW W; convw_load(p.conv_w, p.conv_b, 2048 + g * 128 + ng * 8, W); float o[4][8];
#pragma unroll
                    for (int r = 0; r < 4; ++r) conv_row<4>(rawB, W, r, o[r]);
#pragma unroll
                    for (int e = 0; e < 8; ++e) { u32x2 w; w.x = cvt_pk_bf16(o[0][e], o[1][e]); w.y = cvt_pk_bf16(o[2][e], o[3][e]); *(LAS u32x2*)(sBT + (ng * 8 + e) * 136 + rb * 4) = w; } }
                const int hsel = ng >> 3, pg = ng & 7;
                u32x4 rawX[7]; ConvW W;
#define P2_SSD_LOADS(HP) do { const int ch_ = (8 * g + 2 * (HP) + hsel) * 64 + pg * 8; conv_load<4>(PROJ, t0 + rb * 4, ch_, rawX); convw_load(p.conv_w, p.conv_b, ch_, W); } while (0)
                P2_SSD_LOADS(0);
#pragma unroll 1
                for (int hp = 0; hp < 4; ++hp) {
                    const int hh = 2 * hp + hsel;
                    __syncthreads();
                    { const float aclast = sAc[hh * 128 + 127]; float o[4][8];
#pragma unroll
                        for (int r = 0; r < 4; ++r) { conv_row<4>(rawX, W, r, o[r]); const int l = rb * 4 + r; const float sc = sDt[hh * 128 + l] * __expf(aclast - sAc[hh * 128 + l]);
#pragma unroll
                            for (int e = 0; e < 8; ++e) o[r][e] *= sc; }
#pragma unroll
                        for (int e = 0; e < 8; ++e) { u32x2 w; w.x = cvt_pk_bf16(o[0][e], o[1][e]); w.y = cvt_pk_bf16(o[2][e], o[3][e]); *(LAS u32x2*)(sXT + hsel * 8704 + (pg * 8 + e) * 136 + rb * 4) = w; } }
                    if (hp < 3) P2_SSD_LOADS(hp + 1);
                    __syncthreads();
#pragma unroll
                    for (int hs = 0; hs < 2; ++hs) { const int h2 = 8 * g + 2 * hp + hs;
                        f32x4 acc[4];
#pragma unroll
                        for (int pt = 0; pt < 4; ++pt) acc[pt] = (f32x4){0.f, 0.f, 0.f, 0.f};
#pragma unroll
                        for (int ks = 0; ks < 4; ++ks) { const bf16x8 bfr = LDFRAG(sBT, 16 * wid + (lane & 15), 136, 32 * ks + 8 * (lane >> 4));
#pragma unroll
                            for (int pt = 0; pt < 4; ++pt) { const bf16x8 afr = LDFRAG(sXT + hs * 8704, 16 * pt + (lane & 15), 136, 32 * ks + 8 * (lane >> 4)); acc[pt] = MFMA16(bfr, afr, acc[pt]); } }
#pragma unroll
                        for (int pt = 0; pt < 4; ++pt) { u32x2 o; o.x = cvt_pk_bf16(acc[pt][0], acc[pt][1]); o.y = cvt_pk_bf16(acc[pt][2], acc[pt][3]);
                            *(LAS u32x2*)(sOutS + hs * 8704 + (16 * pt + (lane & 15)) * 136 + 16 * wid + 4 * (lane >> 4)) = o; }
                        if (tid == 0) CDEC[c * 32 + h2] = __expf(sAc[(2 * hp + hs) * 128 + 127]);
                    }
                    __syncthreads();
#pragma unroll
                    for (int j = 0; j < 4; ++j) { const int i = tid + 512 * j, hs = i >> 10, r = i & 1023;
                        *(u32x4*)(STATES + (size_t)(c * 32 + 8 * g + 2 * hp + hs) * 8192 + (size_t)r * 8) = *(const LAS u32x4*)(sOutS + hs * 8704 + (r >> 4) * 136 + (r & 15) * 8); }
                }
            }
        }
}
__device__ __forceinline__ void p2_mlstm(const Params& p, LAS unsigned char* lds, const int bid, const int G, const int tid, const int lane, const int wid) {
    unsigned char* ws = p.ws;
    bf16_t* STATES = (bf16_t*)(ws + WS_STATES); bf16_t* PROJ = (bf16_t*)(ws + WS_PROJ); bf16_t* CLOC = (bf16_t*)(ws + WS_CLOC);
    float* SM = (float*)(ws + WS_SM); float* NLOC = (float*)(ws + WS_NLOC); float* BLAST = (float*)(ws + WS_BLAST); float* MLOC = (float*)(ws + WS_MLOC);
    float* PM = (float*)(ws + WS_PM); float* CDEC = (float*)(ws + WS_CDEC);
    (void)STATES; (void)PROJ; (void)CLOC; (void)SM; (void)NLOC; (void)BLAST; (void)MLOC; (void)PM; (void)CDEC;
        {
            LAS bf16_t* sVT = (LAS bf16_t*)(lds); LAS bf16_t* sKT = (LAS bf16_t*)(lds + 36864); LAS float* sW = (LAS float*)(lds + 55296);
            LAS bf16_t* sOut = (LAS bf16_t*)(lds + 56320);
            const int ks0 = (tid >> 4) * 2, kg = tid & 15, vs0 = (tid >> 5) * 4, vg = tid & 31;
            u32x4 kr[2], vr[4]; float smi = 0.f, smf = 0.f;
#define P2_ML_LOADS(UNIT) do { const int c_ = (UNIT) >> 3, h_ = (UNIT) & 7, t_ = c_ * 64; \
        _Pragma("unroll") for (int r = 0; r < 2; ++r) kr[r] = *(const u32x4*)(PROJ + (size_t)(t_ + ks0 + r) * NPROJ + K_OFF + h_ * 128 + kg * 8); \
        _Pragma("unroll") for (int r = 0; r < 4; ++r) vr[r] = *(const u32x4*)(PROJ + (size_t)(t_ + vs0 + r) * NPROJ + V_OFF + h_ * 256 + vg * 8); \
        smi = SM[(size_t)(t_ + lane) * NSM + 32 + h_]; smf = SM[(size_t)(t_ + lane) * NSM + 40 + h_]; } while (0)
            if (bid < 1024) P2_ML_LOADS(bid);
            for (int unit = bid; unit < 1024; unit += G) { const int c = unit >> 3, h = unit & 7;
                const float li = softcap_f(smi + sload_f(p.i_bias, h));
                const float lf = logsigmoid_f(softcap_f(smf + sload_f(p.f_bias, h)));
                const float bc = wave_scan_add(lf, lane); const float bl = __shfl(bc, 63);
                const float a = bl - bc + li; const float ml = wave_max(a); const float w = __expf(a - ml);
                __syncthreads();
                if (wid == 0) sW[lane] = w;
                { const float sc = 0.08838834764831845f; const unsigned k0[4] = {kr[0].x, kr[0].y, kr[0].z, kr[0].w}, k1[4] = {kr[1].x, kr[1].y, kr[1].z, kr[1].w};
#pragma unroll
                    for (int q = 0; q < 4; ++q) { *(LAS unsigned*)(sKT + (kg * 8 + 2 * q) * 72 + ks0) = cvt_pk_bf16(bflo(k0[q]) * sc, bflo(k1[q]) * sc);
                        *(LAS unsigned*)(sKT + (kg * 8 + 2 * q + 1) * 72 + ks0) = cvt_pk_bf16(bfhi(k0[q]) * sc, bfhi(k1[q]) * sc); } }
                __syncthreads();
                { const float w0 = sW[vs0], w1 = sW[vs0 + 1], w2 = sW[vs0 + 2], w3 = sW[vs0 + 3];
                    const unsigned v0[4] = {vr[0].x, vr[0].y, vr[0].z, vr[0].w}, v1[4] = {vr[1].x, vr[1].y, vr[1].z, vr[1].w}, v2[4] = {vr[2].x, vr[2].y, vr[2].z, vr[2].w}, v3[4] = {vr[3].x, vr[3].y, vr[3].z, vr[3].w};
#pragma unroll
                    for (int q = 0; q < 4; ++q) { u32x2 lo, hi; lo.x = cvt_pk_bf16(bflo(v0[q]) * w0, bflo(v1[q]) * w1); lo.y = cvt_pk_bf16(bflo(v2[q]) * w2, bflo(v3[q]) * w3);
                        hi.x = cvt_pk_bf16(bfhi(v0[q]) * w0, bfhi(v1[q]) * w1); hi.y = cvt_pk_bf16(bfhi(v2[q]) * w2, bfhi(v3[q]) * w3);
                        *(LAS u32x2*)(sVT + (vg * 8 + 2 * q) * 72 + vs0) = lo; *(LAS u32x2*)(sVT + (vg * 8 + 2 * q + 1) * 72 + vs0) = hi; } }
                if (unit + G < 1024) P2_ML_LOADS(unit + G);
                __syncthreads();
                f32x4 acc[16];
#pragma unroll
                for (int vt = 0; vt < 16; ++vt) acc[vt] = (f32x4){0.f, 0.f, 0.f, 0.f};
#pragma unroll
                for (int ks = 0; ks < 2; ++ks) { const bf16x8 bfr = LDFRAG(sKT, 16 * wid + (lane & 15), 72, 32 * ks + 8 * (lane >> 4));
#pragma unroll
                    for (int vt = 0; vt < 16; ++vt) { const bf16x8 afr = LDFRAG(sVT, 16 * vt + (lane & 15), 72, 32 * ks + 8 * (lane >> 4)); acc[vt] = MFMA16(bfr, afr, acc[vt]); } }
#pragma unroll
                for (int vt = 0; vt < 16; ++vt) { u32x2 o; o.x = cvt_pk_bf16(acc[vt][0], acc[vt][1]); o.y = cvt_pk_bf16(acc[vt][2], acc[vt][3]);
                    *(LAS u32x2*)(sOut + (16 * vt + (lane & 15)) * 136 + 16 * wid + 4 * (lane >> 4)) = o; }
                __syncthreads();
#pragma unroll
                for (int j = 0; j < 8; ++j) { const int i = tid + 512 * j; *(u32x4*)(CLOC + (size_t)(c * 8 + h) * 32768 + (size_t)i * 8) = *(const LAS u32x4*)(sOut + (i >> 4) * 136 + (i & 15) * 8); }
                if (tid < 128) { float sacc = 0.f;
#pragma unroll
                    for (int j = 0; j < 8; ++j) { const u32x4 r = *(const LAS u32x4*)(sKT + tid * 72 + 8 * j); const LAS float* wp = sW + 8 * j;
                        sacc += bflo(r.x) * wp[0] + bfhi(r.x) * wp[1] + bflo(r.y) * wp[2] + bfhi(r.y) * wp[3] + bflo(r.z) * wp[4] + bfhi(r.z) * wp[5] + bflo(r.w) * wp[6] + bfhi(r.w) * wp[7]; }
                    NLOC[(size_t)(c * 8 + h) * 128 + tid] = sacc; }
                if (tid == 0) { BLAST[c * 8 + h] = bl; MLOC[c * 8 + h] = ml; }
            }
        }
}
__device__ __forceinline__ void p4_ssd(const Params& p, LAS unsigned char* lds, const int bid, const int G, const int tid, const int lane, const int wid) {
    unsigned char* ws = p.ws;
    bf16_t* STATES = (bf16_t*)(ws + WS_STATES); bf16_t* PROJ = (bf16_t*)(ws + WS_PROJ); bf16_t* CLOC = (bf16_t*)(ws + WS_CLOC);
    float* SM = (float*)(ws + WS_SM); float* NLOC = (float*)(ws + WS_NLOC); float* BLAST = (float*)(ws + WS_BLAST); float* MLOC = (float*)(ws + WS_MLOC);
    float* PM = (float*)(ws + WS_PM); float* CDEC = (float*)(ws + WS_CDEC);
    (void)STATES; (void)PROJ; (void)CLOC; (void)SM; (void)NLOC; (void)BLAST; (void)MLOC; (void)PM; (void)CDEC;
        {
            LAS bf16_t* sB = (LAS bf16_t*)(lds); LAS bf16_t* sM = (LAS bf16_t*)(lds);
            LAS bf16_t* sC = (LAS bf16_t*)(lds + 34816); LAS bf16_t* sXT = (LAS bf16_t*)(lds + 69632); LAS bf16_t* sXs = (LAS bf16_t*)(lds + 87040);
            LAS bf16_t* sS = (LAS bf16_t*)(lds + 105472); LAS float* sDt = (LAS float*)(lds + 122880); LAS float* sAc = (LAS float*)(lds + 126976);
            LAS float* sCW = (LAS float*)(lds + 131072);
            for (int unit = bid; unit < 256; unit += G) { const int c = unit >> 2, g = unit & 3, t0 = c * 128;
                {
                    const int which = tid >> 8, rb = (tid >> 4) & 15, ng = tid & 15, ch0 = 2048 + which * 512 + g * 128 + ng * 8;
                    u32x4 raw[11]; conv_load<8>(PROJ, t0 + rb * 8, ch0, raw); ConvW W; convw_load(p.conv_w, p.conv_b, ch0, W);
                    float cwv[5];
#pragma unroll
                    for (int q = 0; q < 5; ++q) { const int i = tid + 512 * q, hh2 = i / 320, r2 = i % 320, tap = r2 >> 6, ch = (8 * g + hh2) * 64 + (r2 & 63); cwv[q] = tap < 4 ? p.conv_w[tap * 3072 + ch] : p.conv_b[ch]; }
                    __syncthreads();
#pragma unroll
                    for (int q = 0; q < 5; ++q) sCW[tid + 512 * q] = cwv[q];
                    ssd_gates(p, SM, c, g, sDt, sAc, wid, lane);
                    LAS bf16_t* dst = (which ? sC : sB) + (rb * 8) * 136 + ng * 8;
#pragma unroll
                    for (int r = 0; r < 8; ++r) { float o[8]; conv_row<8>(raw, W, r, o); *(LAS u32x4*)(dst + r * 136) = pack8(o); }
                }
                __syncthreads();
                const int ll = lane & 15, lq = lane >> 4, l = 16 * wid + ll;
                f32x4 cb[8];
#pragma unroll
                for (int st = 0; st < 8; ++st) cb[st] = (f32x4){0.f, 0.f, 0.f, 0.f};
#pragma unroll
                for (int ks = 0; ks < 4; ++ks) { const bf16x8 cfr = LDFRAG(sC, l, 136, 32 * ks + 8 * lq);
#pragma unroll
                    for (int st = 0; st < 8; ++st) { const bf16x8 bfr = LDFRAG(sB, 16 * st + ll, 136, 32 * ks + 8 * lq); cb[st] = MFMA16(bfr, cfr, cb[st]); } }
                __syncthreads();
                float ss = 0.f;
                LAS bf16_t* slab = sM + wid * 16 * 136;
                const int nks = (16 * wid + 15) / 32 + 1;
                const int xrb = tid >> 3, xpg = tid & 7;
                u32x4 rawx[5], sv[2]; u32x2 zr[4];
#define SSD_HEAD_LOADS(HH) do { const int h_ = 8 * g + (HH); conv_load<2>(PROJ, t0 + xrb * 2, h_ * 64 + xpg * 8, rawx); \
        _Pragma("unroll") for (int it = 0; it < 2; ++it) { const int i = tid + 512 * it; sv[it] = *(const u32x4*)(STATES + ((size_t)(c * 32 + h_) * 64 + (i >> 4)) * 128 + (i & 15) * 8); } \
        _Pragma("unroll") for (int pt = 0; pt < 4; ++pt) zr[pt] = *(const u32x2*)(PROJ + (size_t)(t0 + l) * NPROJ + Z_OFF + h_ * 64 + 16 * pt + 4 * lq); } while (0)
                SSD_HEAD_LOADS(0);
#pragma unroll 1
                for (int hh = 0; hh < 8; ++hh) { const int h = 8 * g + hh;
                    if (hh > 0) __syncthreads();
                    { ConvW W; { const LAS float* wp = sCW + hh * 320 + xpg * 8;
#pragma unroll
                            for (int tap = 0; tap < 4; ++tap) { W.w[tap][0] = *(const LAS f32x4*)(wp + tap * 64); W.w[tap][1] = *(const LAS f32x4*)(wp + tap * 64 + 4); }
                            W.b[0] = *(const LAS f32x4*)(wp + 256); W.b[1] = *(const LAS f32x4*)(wp + 260); }
                        float o0[8], o1[8]; conv_row<2>(rawx, W, 0, o0); conv_row<2>(rawx, W, 1, o1);
                        *(LAS u32x4*)(sXs + (xrb * 2) * 72 + xpg * 8) = pack8(o0); *(LAS u32x4*)(sXs + (xrb * 2 + 1) * 72 + xpg * 8) = pack8(o1);
                        const float d0 = sDt[hh * 128 + xrb * 2], d1 = sDt[hh * 128 + xrb * 2 + 1];
#pragma unroll
                        for (int e = 0; e < 8; ++e) *(LAS unsigned*)(sXT + (xpg * 8 + e) * 136 + xrb * 2) = cvt_pk_bf16(o0[e] * d0, o1[e] * d1); }
#pragma unroll
                    for (int it = 0; it < 2; ++it) { const int i = tid + 512 * it; *(LAS u32x4*)(sS + (i >> 4) * 136 + (i & 15) * 8) = sv[it]; }
                    u32x2 zc[4];
#pragma unroll
                    for (int pt = 0; pt < 4; ++pt) zc[pt] = zr[pt];
                    if (hh < 7) SSD_HEAD_LOADS(hh + 1);
                    const float acl = sAc[hh * 128 + l];
#pragma unroll
                    for (int st = 0; st < 8; ++st) { float mv[4]; const f32x4 acs = *(const LAS f32x4*)(sAc + hh * 128 + 16 * st + 4 * lq);
#pragma unroll
                        for (int j = 0; j < 4; ++j) { const int sidx = 16 * st + 4 * lq + j; mv[j] = (sidx <= l) ? cb[st][j] * __expf(acl - acs[j]) : 0.f; }
                        u32x2 w; w.x = cvt_pk_bf16(mv[0], mv[1]); w.y = cvt_pk_bf16(mv[2], mv[3]);
                        *(LAS u32x2*)(slab + ll * 136 + 16 * st + 4 * lq) = w; }
                    __syncthreads();
                    f32x4 ad[4], ao[4];
#pragma unroll
                    for (int pt = 0; pt < 4; ++pt) { ad[pt] = (f32x4){0.f, 0.f, 0.f, 0.f}; ao[pt] = (f32x4){0.f, 0.f, 0.f, 0.f}; }
#pragma unroll
                    for (int ks = 0; ks < 4; ++ks) if (ks < nks) { const bf16x8 mfr = LDFRAG(slab, ll, 136, 32 * ks + 8 * lq);
#pragma unroll
                        for (int pt = 0; pt < 4; ++pt) { const bf16x8 xfr = LDFRAG(sXT, 16 * pt + ll, 136, 32 * ks + 8 * lq); ad[pt] = MFMA16(xfr, mfr, ad[pt]); } }
#pragma unroll
                    for (int ks = 0; ks < 4; ++ks) { const bf16x8 cfr = LDFRAG(sC, l, 136, 32 * ks + 8 * lq);
#pragma unroll
                        for (int pt = 0; pt < 4; ++pt) { const bf16x8 sfr = LDFRAG(sS, 16 * pt + ll, 136, 32 * ks + 8 * lq); ao[pt] = MFMA16(sfr, cfr, ao[pt]); } }
                    const float eal = __expf(acl), dsk = sload_f(p.d_skip, h);
#pragma unroll
                    for (int pt = 0; pt < 4; ++pt) { const int pc = 16 * pt + 4 * lq;
                        const u32x2 xr = *(const LAS u32x2*)(sXs + l * 72 + pc);
                        const f32x4 xs = (f32x4){bflo(xr.x), bfhi(xr.x), bflo(xr.y), bfhi(xr.y)}; const f32x4 zz = (f32x4){bflo(zc[pt].x), bfhi(zc[pt].x), bflo(zc[pt].y), bfhi(zc[pt].y)};
                        f32x4 y = ad[pt] + ao[pt] * eal + xs * dsk;
#pragma unroll
                        for (int j = 0; j < 4; ++j) { y[j] *= silu_f(zz[j]); ss += y[j] * y[j]; }
                        u32x2 w; w.x = cvt_pk_bf16(y[0], y[1]); w.y = cvt_pk_bf16(y[2], y[3]);
                        *(u32x2*)(PROJ + (size_t)(t0 + l) * NPROJ + Z_OFF + h * 64 + pc) = w; }
                }
                ss += __shfl_xor(ss, 16); ss += __shfl_xor(ss, 32);
                const float rstd = __builtin_amdgcn_rsqf(ss * (1.f / 512.f) + EPS);
#pragma unroll
                for (int hh = 0; hh < 8; ++hh)
#pragma unroll
                    for (int pt = 0; pt < 4; ++pt) { const int col = (8 * g + hh) * 64 + 16 * pt + 4 * lq; const f32x4 gv = *(const f32x4*)(p.ssd_norm_g + col);
                        u32x2* yp = (u32x2*)(PROJ + (size_t)(t0 + l) * NPROJ + Z_OFF + col); const u32x2 yr = *yp;
                        const f32x4 y = (f32x4){bflo(yr.x), bfhi(yr.x), bflo(yr.y), bfhi(yr.y)} * rstd * gv;
                        u32x2 w; w.x = cvt_pk_bf16(y[0], y[1]); w.y = cvt_pk_bf16(y[2], y[3]);
                        *yp = w; }
            }
        }
}
__device__ __forceinline__ void p4_mlstm(const Params& p, LAS unsigned char* lds, const int bid, const int G, const int tid, const int lane, const int wid) {
    unsigned char* ws = p.ws;
    bf16_t* STATES = (bf16_t*)(ws + WS_STATES); bf16_t* PROJ = (bf16_t*)(ws + WS_PROJ); bf16_t* CLOC = (bf16_t*)(ws + WS_CLOC);
    float* SM = (float*)(ws + WS_SM); float* NLOC = (float*)(ws + WS_NLOC); float* BLAST = (float*)(ws + WS_BLAST); float* MLOC = (float*)(ws + WS_MLOC);
    float* PM = (float*)(ws + WS_PM); float* CDEC = (float*)(ws + WS_CDEC);
    (void)STATES; (void)PROJ; (void)CLOC; (void)SM; (void)NLOC; (void)BLAST; (void)MLOC; (void)PM; (void)CDEC;
        {
            LAS bf16_t* sQ = (LAS bf16_t*)(lds); LAS bf16_t* sK = (LAS bf16_t*)(lds + 17408); LAS bf16_t* sVT = (LAS bf16_t*)(lds + 34816);
            LAS bf16_t* sSl = (LAS bf16_t*)(lds + 71680); LAS float* sBc = (LAS float*)(lds + 90112); LAS float* sG = sBc + 64; LAS float* sMt = sBc + 128; LAS float* sWi = sBc + 192;
            LAS float* sRow = (LAS float*)(lds + 91136); LAS bf16_t* sPC = (LAS bf16_t*)(lds + 91648);
            const int lt = wid & 3, vh = wid >> 2, ll = lane & 15, lq = lane >> 4, l = 16 * lt + ll;
            const int qs0 = (tid >> 4) * 2, kg = tid & 15, vs0 = (tid >> 5) * 4, vg = tid & 31;
            u32x4 qr[2], kr[2], vr[4], pc[8]; f32x4 pnr = (f32x4){0.f, 0.f, 0.f, 0.f}; float smi = 0.f, smf = 0.f, pmv = 0.f;
            LAS float* sPN = (LAS float*)(lds + 161280);
#define P4_ML_LOADS(UNIT) do { const int c_ = (UNIT) >> 3, h_ = (UNIT) & 7, t_ = c_ * 64; \
        _Pragma("unroll") for (int r = 0; r < 2; ++r) { qr[r] = *(const u32x4*)(PROJ + (size_t)(t_ + qs0 + r) * NPROJ + Q_OFF + h_ * 128 + kg * 8); kr[r] = *(const u32x4*)(PROJ + (size_t)(t_ + qs0 + r) * NPROJ + K_OFF + h_ * 128 + kg * 8); } \
        _Pragma("unroll") for (int j = 0; j < 8; ++j) pc[j] = *(const u32x4*)(CLOC + (size_t)(c_ * 8 + h_) * 32768 + (size_t)(tid + 512 * j) * 8); \
        if (tid < 32) pnr = *(const f32x4*)(NLOC + (size_t)(c_ * 8 + h_) * 128 + tid * 4); \
        smi = SM[(size_t)(t_ + lane) * NSM + 32 + h_]; smf = SM[(size_t)(t_ + lane) * NSM + 40 + h_]; pmv = PM[c_ * 8 + h_]; } while (0)
            if (bid < 1024) P4_ML_LOADS(bid);
            for (int unit = bid; unit < 1024; unit += G) { const int c = unit >> 3, h = unit & 7, t0 = c * 64;
#pragma unroll
                for (int r = 0; r < 4; ++r) vr[r] = *(const u32x4*)(PROJ + (size_t)(t0 + vs0 + r) * NPROJ + V_OFF + h * 256 + vg * 8);
                u32x2 orr[8];
#pragma unroll
                for (int vt = 0; vt < 8; ++vt) orr[vt] = *(const u32x2*)(PROJ + (size_t)(t0 + l) * NPROJ + O_OFF + h * 256 + 128 * vh + 16 * vt + 4 * lq);
                {
                    const float li = softcap_f(smi + sload_f(p.i_bias, h));
                    const float lf = logsigmoid_f(softcap_f(smf + sload_f(p.f_bias, h)));
                    const float bc = wave_scan_add(lf, lane); const float gg = li - bc; const float mp = pmv;
                    const float il = bc + mp; const float mi = bc + wave_scan_max(gg, lane); const float mt = fmaxf(il, mi); const float wi = __expf(il - mt);
                    __syncthreads();
                    if (wid == 0) { sBc[lane] = bc; sG[lane] = gg; sMt[lane] = mt; sWi[lane] = wi; }
                }
                { const float sc = 0.08838834764831845f;
#pragma unroll
                    for (int r = 0; r < 2; ++r) { *(LAS u32x4*)(sQ + (qs0 + r) * 136 + kg * 8) = qr[r];
                        u32x4 w; w.x = cvt_pk_bf16(bflo(kr[r].x) * sc, bfhi(kr[r].x) * sc); w.y = cvt_pk_bf16(bflo(kr[r].y) * sc, bfhi(kr[r].y) * sc); w.z = cvt_pk_bf16(bflo(kr[r].z) * sc, bfhi(kr[r].z) * sc); w.w = cvt_pk_bf16(bflo(kr[r].w) * sc, bfhi(kr[r].w) * sc);
                        *(LAS u32x4*)(sK + (qs0 + r) * 136 + kg * 8) = w; }
                    const unsigned v0[4] = {vr[0].x, vr[0].y, vr[0].z, vr[0].w}, v1[4] = {vr[1].x, vr[1].y, vr[1].z, vr[1].w}, v2[4] = {vr[2].x, vr[2].y, vr[2].z, vr[2].w}, v3[4] = {vr[3].x, vr[3].y, vr[3].z, vr[3].w};
#pragma unroll
                    for (int q = 0; q < 4; ++q) { u32x2 lo, hi; lo.x = (v0[q] & 0xffffu) | (v1[q] << 16); lo.y = (v2[q] & 0xffffu) | (v3[q] << 16);
                        hi.x = (v0[q] >> 16) | (v1[q] & 0xffff0000u); hi.y = (v2[q] >> 16) | (v3[q] & 0xffff0000u);
                        *(LAS u32x2*)(sVT + (vg * 8 + 2 * q) * 72 + vs0) = lo; *(LAS u32x2*)(sVT + (vg * 8 + 2 * q + 1) * 72 + vs0) = hi; } }
#pragma unroll
                for (int j = 0; j < 8; ++j) { const int i = tid + 512 * j; *(LAS u32x4*)(sPC + (i >> 4) * 136 + (i & 15) * 8) = pc[j]; }
                if (tid < 32) *(LAS f32x4*)(sPN + tid * 4) = pnr;
                if (unit + G < 1024) P4_ML_LOADS(unit + G);
                __syncthreads();
                f32x4 sacc[4];
#pragma unroll
                for (int st = 0; st < 4; ++st) sacc[st] = (f32x4){0.f, 0.f, 0.f, 0.f};
#pragma unroll
                for (int ks = 0; ks < 4; ++ks) { const bf16x8 qfr = LDFRAG(sQ, l, 136, 32 * ks + 8 * lq);
#pragma unroll
                    for (int st = 0; st < 4; ++st) if (st <= lt) { const bf16x8 kfr = LDFRAG(sK, 16 * st + ll, 136, 32 * ks + 8 * lq); sacc[st] = MFMA16(kfr, qfr, sacc[st]); } }
                LAS bf16_t* slab = sSl + wid * 16 * 72;
                const float mtl = sMt[l], base = sBc[l] - mtl, wil = sWi[l];
                float nq1 = 0.f;
#pragma unroll
                for (int st = 0; st < 4; ++st) { float sv[4]; const f32x4 gs = *(const LAS f32x4*)(sG + 16 * st + 4 * lq);
#pragma unroll
                    for (int j = 0; j < 4; ++j) { const int sidx = 16 * st + 4 * lq + j; sv[j] = (sidx <= l) ? sacc[st][j] * __expf(base + gs[j]) : 0.f; nq1 += sv[j]; }
                    u32x2 w; w.x = cvt_pk_bf16(sv[0], sv[1]); w.y = cvt_pk_bf16(sv[2], sv[3]);
                    *(LAS u32x2*)(slab + ll * 72 + 16 * st + 4 * lq) = w; }
                nq1 += __shfl_xor(nq1, 16); nq1 += __shfl_xor(nq1, 32);
                float nq2 = 0.f;
#pragma unroll
                for (int kk = 0; kk < 4; ++kk) { const u32x4 qq = *(const LAS u32x4*)(sQ + l * 136 + 32 * lq + 8 * kk); const f32x4 n0 = *(const LAS f32x4*)(sPN + 32 * lq + 8 * kk), n1 = *(const LAS f32x4*)(sPN + 32 * lq + 8 * kk + 4);
                    nq2 += bflo(qq.x) * n0[0] + bfhi(qq.x) * n0[1] + bflo(qq.y) * n0[2] + bfhi(qq.y) * n0[3] + bflo(qq.z) * n1[0] + bfhi(qq.z) * n1[1] + bflo(qq.w) * n1[2] + bfhi(qq.w) * n1[3]; }
                nq2 += __shfl_xor(nq2, 16); nq2 += __shfl_xor(nq2, 32);
                const float nq = nq1 + wil * nq2; const float den = fmaxf(fabsf(nq), __expf(-mtl)); const float inv = 1.0f / den;
                LDS_WAIT();
                f32x4 a1[8], a2[8];
#pragma unroll
                for (int vt = 0; vt < 8; ++vt) { a1[vt] = (f32x4){0.f, 0.f, 0.f, 0.f}; a2[vt] = (f32x4){0.f, 0.f, 0.f, 0.f}; }
#pragma unroll
                for (int ks = 0; ks < 2; ++ks) if (32 * ks <= 16 * lt + 15) { const bf16x8 sfr = LDFRAG(slab, ll, 72, 32 * ks + 8 * lq);
#pragma unroll
                    for (int vt = 0; vt < 8; ++vt) { const bf16x8 vfr = LDFRAG(sVT, 128 * vh + 16 * vt + ll, 72, 32 * ks + 8 * lq); a1[vt] = MFMA16(vfr, sfr, a1[vt]); } }
#pragma unroll 1
                for (int ks = 0; ks < 4; ++ks) { const bf16x8 qfr = LDFRAG(sQ, l, 136, 32 * ks + 8 * lq);
#pragma unroll
                    for (int vt = 0; vt < 8; ++vt) { const bf16x8 cfr = LDFRAG(sPC, 128 * vh + 16 * vt + ll, 136, 32 * ks + 8 * lq); a2[vt] = MFMA16(cfr, qfr, a2[vt]); } }
                float hs = 0.f;
#pragma unroll
                for (int vt = 0; vt < 8; ++vt) { a1[vt] = (a1[vt] + a2[vt] * wil) * inv; hs += (a1[vt][0] * a1[vt][0] + a1[vt][1] * a1[vt][1]) + (a1[vt][2] * a1[vt][2] + a1[vt][3] * a1[vt][3]); }
                hs += __shfl_xor(hs, 16); hs += __shfl_xor(hs, 32);
                if (lq == 0) sRow[vh * 64 + l] = hs;
                f32x4 gvv[8];
#pragma unroll
                for (int vt = 0; vt < 8; ++vt) gvv[vt] = *(const f32x4*)(p.mlstm_norm_g + h * 256 + 128 * vh + 16 * vt + 4 * lq);
                __syncthreads();
                const float rstd = __builtin_amdgcn_rsqf((sRow[l] + sRow[64 + l]) * (1.f / 256.f) + EPS);
#pragma unroll
                for (int vt = 0; vt < 8; ++vt) { const int col = h * 256 + 128 * vh + 16 * vt + 4 * lq; bf16_t* op = PROJ + (size_t)(t0 + l) * NPROJ + O_OFF + col;
                    const f32x4 gv = gvv[vt];
                    const f32x4 ov = (f32x4){bflo(orr[vt].x), bfhi(orr[vt].x), bflo(orr[vt].y), bfhi(orr[vt].y)};
                    f32x4 y;
#pragma unroll
                    for (int j = 0; j < 4; ++j) y[j] = a1[vt][j] * rstd * gv[j] * sigmoid_f(ov[j]);
                    u32x2 w; w.x = cvt_pk_bf16(y[0], y[1]); w.y = cvt_pk_bf16(y[2], y[3]);
                    (void)op; *(LAS u32x2*)(sPC + l * 264 + 128 * vh + 16 * vt + 4 * lq) = w; }
                __syncthreads();
#pragma unroll
                for (int j = 0; j < 4; ++j) { const int i = tid + 512 * j, r = i >> 5, c16 = i & 31;
                    *(u32x4*)(PROJ + (size_t)(t0 + r) * NPROJ + O_OFF + h * 256 + c16 * 8) = *(const LAS u32x4*)(sPC + r * 264 + c16 * 8); }
            }
        }
}

__global__ void __launch_bounds__(512, 2) hymba_fwd(Params p) {
    extern __shared__ __attribute__((aligned(16))) unsigned char lds_raw[];
    LAS unsigned char* lds = (LAS unsigned char*)lds_raw;
    cg::grid_group grid = cg::this_grid();
    const int tid = threadIdx.x, lane = tid & 63, wid = __builtin_amdgcn_readfirstlane(tid >> 6);
    const int G = gridDim.x, bid = blockIdx.x;
    unsigned char* ws = p.ws;
#define WS_PTRS bf16_t* WIN = (bf16_t*)(ws + WS_WIN); bf16_t* U = (bf16_t*)(ws + WS_U); bf16_t* STATES = (bf16_t*)(ws + WS_STATES); bf16_t* H1G = (bf16_t*)(ws + WS_H1G); bf16_t* WD = (bf16_t*)(ws + WS_WD); bf16_t* WOUT = (bf16_t*)(ws + WS_WOUT); bf16_t* PROJ = (bf16_t*)(ws + WS_PROJ); bf16_t* ACT = (bf16_t*)(ws + WS_PROJ); bf16_t* CLOC = (bf16_t*)(ws + WS_CLOC); bf16_t* WGU = (bf16_t*)p.out; float* H1 = (float*)(ws + WS_CLOC); float* SM = (float*)(ws + WS_SM); float* NLOC = (float*)(ws + WS_NLOC); float* BLAST = (float*)(ws + WS_BLAST); float* MLOC = (float*)(ws + WS_MLOC); float* PM = (float*)(ws + WS_PM); float* CDEC = (float*)(ws + WS_CDEC); float* SS1 = (float*)(ws + WS_SS1); float* SS2 = (float*)(ws + WS_SS2);
    const int lo = p.ph_lo, hi = p.ph_hi;
    if (lo == 0 && hi == NPH) { volatile LAS unsigned* xb_st = (volatile LAS unsigned*)(lds + LDS_BYTES - 16); if (tid < 4) xb_st[tid] = 0u; __syncthreads();
        if (tid == 0) (void)xb_add(&((unsigned*)(ws + WS_BAR))[XB_XCNT(xb_xcc_id())], 1u); }
#ifndef PH_MASK
#define PH_MASK 0x1ff
#endif
#define PHASE(k) (((PH_MASK >> (k)) & 1) && lo <= (k) && (k) < hi)
#define SEAM(k) do { if (PHASE(k) && PHASE((k) + 1)) { \
        if (lo == 0 && hi == NPH) { XcdBarrier xb_; xb_.bar = (unsigned*)(p.ws + WS_BAR); xb_.x = xb_xcc_id(); xb_.st = (volatile LAS unsigned*)(lds + LDS_BYTES - 16); xcd_barrier(xb_, wid == 0 && __builtin_amdgcn_mbcnt_hi(~0u, __builtin_amdgcn_mbcnt_lo(~0u, 0u)) == 0u); } \
        else { asm volatile("s_waitcnt vmcnt(0) lgkmcnt(0)" ::: "memory"); grid.sync(); asm volatile("s_waitcnt vmcnt(0)" ::: "memory"); __syncthreads(); } } } while (0)

    if (PHASE(0)) {
        WS_PTRS
        LAS float* scr = (LAS float*)(lds + wid * 16640);
        const int gw = bid * 8 + wid, NGW = G * 8;
        convert_items(p, ws, 0, gw, 32 * 180, NGW, scr, lane);
        for (int m = gw; m < L; m += NGW) {
            const f32x4* xr = (const f32x4*)(p.x + (size_t)m * DM) + lane; const f32x4* gr = (const f32x4*)p.norm_mix_g + lane;
            f32x4 v[8]; float s = 0.f;
#pragma unroll
            for (int j = 0; j < 8; ++j) { v[j] = __builtin_nontemporal_load(xr + 64 * j); s += (v[j][0] * v[j][0] + v[j][1] * v[j][1]) + (v[j][2] * v[j][2] + v[j][3] * v[j][3]); }
            const float rstd = __builtin_amdgcn_rsqf(wave_sum(s) * (1.f / DM) + EPS);
            u32x2* o8 = (u32x2*)(U + (size_t)m * DM) + lane;
#pragma unroll
            for (int j = 0; j < 8; ++j) { const f32x4 gv = gr[64 * j]; u32x2 w; w.x = cvt_pk_bf16(v[j][0] * rstd * gv[0], v[j][1] * rstd * gv[1]); w.y = cvt_pk_bf16(v[j][2] * rstd * gv[2], v[j][3] * rstd * gv[3]); o8[64 * j] = w; }
        }
        for (int i = bid * 512 + tid; i < 2 * L + 32 * 64; i += G * 512) SS1[i] = 0.f;
    }
    SEAM(0);

    if (PHASE(1)) {
        WS_PTRS
        pg8::Gemm g{U, WIN, L, NIN_PAD, DM, DM}; pg8::StaticOrder S; S.init(L, NIN_PAD, G, bid);
        EpiProj E{PROJ, SM};
        pg8::gemm_phase<EpiProj>(lds, g, S, E, tid);
        { const int nfull = (L / 256) * (NIN_PAD / 256) - 5 * G;
            if (G == 256 && bid >= nfull) { convert_items(p, ws, 1, (bid - nfull) * 8 + wid, 64 * 32, (G - nfull) * 8, (LAS float*)(lds + wid * 16640), lane);
                convert_items(p, ws, 2, (bid - nfull) * 8 + wid, WGU_TAIL_ITEMS, (G - nfull) * 8, (LAS float*)(lds + wid * 16640), lane); }
            else if (G != 256) { convert_items(p, ws, 1, bid * 8 + wid, 64 * 32, G * 8, (LAS float*)(lds + wid * 16640), lane);
                convert_items(p, ws, 2, bid * 8 + wid, 32 * 176, G * 8, (LAS float*)(lds + wid * 16640), lane); } }
    }
    SEAM(1);

    if (PHASE(2)) {
        WS_PTRS
        p2_ssd(p, lds, bid, G, tid, lane, wid); p2_mlstm(p, lds, bid, G, tid, lane, wid);
    }
    SEAM(2);

    if (PHASE(3)) {
        WS_PTRS
        const int NT = G * 256;
        for (int it0 = (tid < 256) ? bid * 256 + tid : ((tid == 256) ? 2 * 32768 + bid : 0x7fffffff); it0 < 2 * 32768 + 256; it0 += (tid < 256) ? NT : G) {
            if (tid < 256 && it0 >= 2 * 32768) break;
            int it;
            if (it0 < 2 * 32768) { const int blk = it0 >> 8, r = it0 & 255; it = (r < 128) ? (blk * 128 + r) : (32768 + blk * 128 + (r - 128)); } else it = it0;
            if (it < 32768) { const int h = it >> 10, e = (it & 1023) * 8; f32x4 s0 = (f32x4){0.f, 0.f, 0.f, 0.f}, s1 = s0;
                bf16_t* base = STATES + (size_t)h * 8192 + e;
                u32x4 lA[8], lB[8]; float dA[8], dB[8];
#define SSD_SCAN_LOAD(L_, D_, C0) do { _Pragma("unroll") for (int u = 0; u < 8; ++u) { L_[u] = __builtin_nontemporal_load((const u32x4*)(base + (size_t)((C0) + u) * 262144)); D_[u] = CDEC[((C0) + u) * 32 + h]; } } while (0)
#define SSD_SCAN_PROC(L_, D_, C0) do { _Pragma("unroll") for (int u = 0; u < 8; ++u) { u32x4 o; o.x = cvt_pk_bf16(s0[0], s0[1]); o.y = cvt_pk_bf16(s0[2], s0[3]); o.z = cvt_pk_bf16(s1[0], s1[1]); o.w = cvt_pk_bf16(s1[2], s1[3]); \
        *(u32x4*)(base + (size_t)((C0) + u) * 262144) = o; \
        const f32x4 l0 = (f32x4){bflo(L_[u].x), bfhi(L_[u].x), bflo(L_[u].y), bfhi(L_[u].y)}, l1 = (f32x4){bflo(L_[u].z), bfhi(L_[u].z), bflo(L_[u].w), bfhi(L_[u].w)}; \
        s0 = s0 * D_[u] + l0; s1 = s1 * D_[u] + l1; } } while (0)
                SSD_SCAN_LOAD(lA, dA, 0);
                for (int c0 = 0; c0 < 64; c0 += 16) { SSD_SCAN_LOAD(lB, dB, c0 + 8); SSD_SCAN_PROC(lA, dA, c0); if (c0 + 16 < 64) SSD_SCAN_LOAD(lA, dA, c0 + 16); SSD_SCAN_PROC(lB, dB, c0 + 8); }
            } else if (it < 32768 + 32768) { const int j = it - 32768, h = j >> 12, e = (j & 4095) * 8; f32x4 C0 = (f32x4){0.f, 0.f, 0.f, 0.f}, C1 = C0; float m = 0.f;
                bf16_t* base = CLOC + (size_t)h * 32768 + e;
                u32x4 lA[8], lB[8]; float bA[8], bB[8], mA[8], mB[8];
#define ML_SCAN_LOAD(L_, B_, M_, C0_) do { _Pragma("unroll") for (int u = 0; u < 8; ++u) { L_[u] = __builtin_nontemporal_load((const u32x4*)(base + (size_t)((C0_) + u) * 262144)); B_[u] = BLAST[((C0_) + u) * 8 + h]; M_[u] = MLOC[((C0_) + u) * 8 + h]; } } while (0)
#define ML_SCAN_PROC(L_, B_, M_, C0_) do { _Pragma("unroll") for (int u = 0; u < 8; ++u) { u32x4 o; o.x = cvt_pk_bf16(C0[0], C0[1]); o.y = cvt_pk_bf16(C0[2], C0[3]); o.z = cvt_pk_bf16(C1[0], C1[1]); o.w = cvt_pk_bf16(C1[2], C1[3]); \
        *(u32x4*)(base + (size_t)((C0_) + u) * 262144) = o; if (e == 0) PM[((C0_) + u) * 8 + h] = m; \
        const float mn = fmaxf(B_[u] + m, M_[u]); const float so = __expf(B_[u] + m - mn), sn = __expf(M_[u] - mn); \
        const f32x4 l0 = (f32x4){bflo(L_[u].x), bfhi(L_[u].x), bflo(L_[u].y), bfhi(L_[u].y)}, l1 = (f32x4){bflo(L_[u].z), bfhi(L_[u].z), bflo(L_[u].w), bfhi(L_[u].w)}; \
        C0 = C0 * so + l0 * sn; C1 = C1 * so + l1 * sn; m = mn; } } while (0)
                ML_SCAN_LOAD(lA, bA, mA, 0);
                for (int c0 = 0; c0 < 128; c0 += 16) { ML_SCAN_LOAD(lB, bB, mB, c0 + 8); ML_SCAN_PROC(lA, bA, mA, c0); if (c0 + 16 < 128) ML_SCAN_LOAD(lA, bA, mA, c0 + 16); ML_SCAN_PROC(lB, bB, mB, c0 + 8); }
            } else { const int j = it - 32768 - 32768, h = j >> 5, e = (j & 31) * 4; f32x4 n = (f32x4){0.f, 0.f, 0.f, 0.f}; float m = 0.f;
                for (int c0 = 0; c0 < 128; c0 += 8) { f32x4 loc[8]; float blv[8], mlv[8];
#pragma unroll
                    for (int u = 0; u < 8; ++u) { loc[u] = *(const f32x4*)(NLOC + (size_t)((c0 + u) * 8 + h) * 128 + e); blv[u] = BLAST[(c0 + u) * 8 + h]; mlv[u] = MLOC[(c0 + u) * 8 + h]; }
#pragma unroll
                    for (int u = 0; u < 8; ++u) { *(f32x4*)(NLOC + (size_t)((c0 + u) * 8 + h) * 128 + e) = n;
                        const float mn = fmaxf(blv[u] + m, mlv[u]); const float so = __expf(blv[u] + m - mn), sn = __expf(mlv[u] - mn);
                        n = n * so + loc[u] * sn; m = mn; } }
            }
        }
    }
    SEAM(3);

    if (PHASE(4)) {
        WS_PTRS
        p4_ssd(p, lds, bid, G, tid, lane, wid); p4_mlstm(p, lds, bid, G, tid, lane, wid);
    }
    SEAM(4);

    if (PHASE(5)) {
        const int lane = (int)__builtin_amdgcn_mbcnt_hi(~0u, __builtin_amdgcn_mbcnt_lo(~0u, 0u)), tid = wid * 64 + lane; (void)lane;
        WS_PTRS
        __syncthreads();
        LAS float* scr = (LAS float*)(lds + wid * 16640);
        const int gw = bid * 8 + wid, NGW = G * 8;
        if (G != 256) convert_items(p, ws, 3, gw, 88 * 32, NGW, scr, lane);
        else convert_items(p, ws, 2, WGU_TAIL_ITEMS + gw, 32 * 176, NGW, scr, lane);
        __syncthreads();
        pg8::Gemm g{PROJ, WOUT, L, DM, 4096, NPROJ}; pg8::StaticOrder S; S.init(L, DM, G, bid);
        if (G == 256) { EpiOutDet E{p.x, H1, H1G, p.norm_ffn_g, (float*)(ws + WS_PART1), (unsigned*)SS2, SS1}; pg8::gemm_phase<EpiOutDet>(lds, g, S, E, tid); }
        else { EpiOut E{p.x, H1, H1G, p.norm_ffn_g, SS1}; pg8::gemm_phase<EpiOut>(lds, g, S, E, tid); }
    }
    SEAM(5);

    if (PHASE(6)) {
        const int lane = (int)__builtin_amdgcn_mbcnt_hi(~0u, __builtin_amdgcn_mbcnt_lo(~0u, 0u)), tid = wid * 64 + lane; (void)lane;
        WS_PTRS
        pg8::Gemm g{H1G, WGU, L, 2 * DFF, DM, DM}; pg8::StaticOrder S; S.init(L, 2 * DFF, G, bid);
        if (G == 256) { EpiGUT<true> E{ACT, SS1}; pg8::gemm_phase<EpiGUT<true>>(lds, g, S, E, tid); }
        else { EpiGUT<false> E{ACT, SS1}; pg8::gemm_phase<EpiGUT<false>>(lds, g, S, E, tid); }
        { const int nfull = (L / 256) * (2 * DFF / 256) - 5 * G;
            if (G == 256 && bid >= nfull) convert_items(p, ws, 3, (bid - nfull) * 8 + wid, 88 * 32, (G - nfull) * 8, (LAS float*)(lds + wid * 16640), lane); }
    }
    SEAM(6);

    if (PHASE(7)) {
        const int lane = (int)__builtin_amdgcn_mbcnt_hi(~0u, __builtin_amdgcn_mbcnt_lo(~0u, 0u)), tid = wid * 64 + lane; (void)lane;
        WS_PTRS
        pg8::Gemm g{ACT, WD, L, DM, DFF, DFF}; pg8::StaticOrder S; S.init(L, DM, G, bid);
        if (G == 256) { EpiDownDet E{H1, p.out, (float*)(ws + WS_PART2), (unsigned*)(ws + WS_CNT), p.final_norm_g, (LAS float*)lds}; pg8::gemm_phase<EpiDownDet>(lds, g, S, E, tid); }
        else { EpiDown E{H1, p.out, SS2}; pg8::gemm_phase<EpiDown>(lds, g, S, E, tid); }
    }
    if (G != 256) {
    SEAM(7);

    if (PHASE(8)) {
        const int lane = (int)__builtin_amdgcn_mbcnt_hi(~0u, __builtin_amdgcn_mbcnt_lo(~0u, 0u)), tid = wid * 64 + lane; (void)lane;
        WS_PTRS
        const int gw = bid * 8 + wid, NGW = G * 8;
        for (int m = gw; m < L; m += NGW) {
            const float rstd = __builtin_amdgcn_rsqf(SS2[m] * (1.f / DM) + EPS);
            f32x4* xr = (f32x4*)(p.out + (size_t)m * DM) + lane; const f32x4* gr = (const f32x4*)p.final_norm_g + lane;
#pragma unroll
            for (int j = 0; j < 8; ++j) { const f32x4 v = xr[64 * j]; xr[64 * j] = v * rstd * gr[64 * j]; }
        }
    }
    }
#undef WS_PTRS
#undef PHASE
#undef SEAM
}

extern "C" void kernel_launch(void* const* d_in, const int* in_sizes, int n_in, void* d_out, int out_size, void* d_ws, size_t ws_size, hipStream_t stream) {
    static int grid = 0;
    if (grid == 0) {
        if (n_in != 18 || out_size != L * DM || ws_size < WS_END) { fprintf(stderr, "kernel_launch: unexpected shapes (n_in %d out %d ws %zu, need ws %zu)\n", n_in, out_size, ws_size, (size_t)WS_END); grid = -1; return; }
        int dev = 0, cus = 0, per_cu = 0;
        hipGetDevice(&dev); hipDeviceGetAttribute(&cus, hipDeviceAttributeMultiprocessorCount, dev);
        if (hipFuncSetAttribute((const void*)hymba_fwd, hipFuncAttributeMaxDynamicSharedMemorySize, LDS_BYTES) != hipSuccess) { fprintf(stderr, "kernel_launch: hipFuncSetAttribute failed\n"); grid = -1; return; }
        if (hipOccupancyMaxActiveBlocksPerMultiprocessor(&per_cu, (const void*)hymba_fwd, 512, LDS_BYTES) != hipSuccess || per_cu < 1) { fprintf(stderr, "kernel_launch: occupancy query failed (%d)\n", per_cu); (void)hipGetLastError(); grid = -1; return; }
        grid = cus * 1;
        fprintf(stderr, "kernel_launch: cus %d per_cu %d grid %d ws %zu\n", cus, per_cu, grid, ws_size);
    }
    if (grid < 0) return;
    Params p{};
    const float** pp = (const float**)&p;
    for (int i = 0; i < 18; ++i) pp[i] = (const float*)d_in[i];
    p.out = (float*)d_out; p.ws = (unsigned char*)d_ws;
    (void)hipMemsetAsync((char*)d_ws + WS_BAR, 0, XCD_BAR_WORDS * sizeof(unsigned), stream);
#if MK_MULTI
    for (int ph = 0; ph < NPH; ++ph) { p.ph_lo = ph; p.ph_hi = ph + 1; hipLaunchKernelGGL(hymba_fwd, dim3(grid), dim3(512), LDS_BYTES, stream, p); }
#elif defined(PROBE_REPEAT)
    {
        void* args[] = {&p};
        p.ph_lo = 0; p.ph_hi = PROBE_REPEAT + 1;
        (void)hipLaunchCooperativeKernel((const void*)hymba_fwd, dim3(grid), dim3(512), args, LDS_BYTES, stream);
        p.ph_lo = PROBE_REPEAT; p.ph_hi = NPH;
        (void)hipLaunchCooperativeKernel((const void*)hymba_fwd, dim3(grid), dim3(512), args, LDS_BYTES, stream);
    }
#else
    p.ph_lo = 0; p.ph_hi = NPH;
    void* args[] = {&p};
    hipError_t e = hipLaunchCooperativeKernel((const void*)hymba_fwd, dim3(grid), dim3(512), args, LDS_BYTES, stream);
    if (e != hipSuccess) fprintf(stderr, "kernel_launch: cooperative launch failed: %s (grid %d)\n", hipGetErrorString(e), grid);
#endif
}
```
